# Optimizing an MI355X kernel written in HIP

```python
import jax, jax.numpy as jnp
from jax import lax
import numpy as np

D_MODEL = 1024
BATCH = 8
SEQ = 2048
DEPTH = 4

N_MIXERS = 2
CONV_WIDTH = 3
ML_HEADS = 4
ML_V_DIM = D_MODEL // ML_HEADS
ML_QK_DIM = ML_V_DIM // 2
ML_QK_W = ML_HEADS * ML_QK_DIM
ML_V_W = ML_HEADS * ML_V_DIM
ML_IN_W = 2 * ML_QK_W + 2 * ML_V_W + 2 * ML_HEADS
ML_CHUNK = 64
GATE_SOFTCAP = 15.0
D_FF = ((8 * D_MODEL // 3 + 127) // 128) * 128
EPS = 1e-6

kernel_name = "hybrid_shortconv_mlstm_convffn_adaln"


def rms_norm(x, g):
    xf = x.astype(jnp.float32)
    y = xf * lax.rsqrt(jnp.mean(xf * xf, axis=-1, keepdims=True) + EPS)
    return (y * g.astype(jnp.float32)).astype(x.dtype)


def modulate(h, shift, scale):
    return h * (1 + scale[:, None, :]) + shift[:, None, :]


def causal_dwconv(x, w):
    k_w = w.shape[0]
    s = x.shape[1]
    xp = jnp.pad(x, ((0, 0), (k_w - 1, 0), (0, 0)))
    y = w[0] * xp[:, 0:s]
    for j in range(1, k_w):
        y = y + w[j] * xp[:, j:j + s]
    return y


def softcap(t):
    return GATE_SOFTCAP * jnp.tanh(t / GATE_SOFTCAP)


def short_conv_mixer(h, w_in, conv_w, w_out):
    bcu = h @ w_in
    gb, gc, u = jnp.split(bcu, 3, axis=-1)
    y = gb * causal_dwconv(gc * u, conv_w)
    return y @ w_out


def mlstm_chunkwise(q, k, v, ig, logf):
    bsz, nh, s, dk = q.shape
    dv = v.shape[-1]
    nc = s // ML_CHUNK

    def to_chunks(t):
        t = t.reshape((bsz, nh, nc, ML_CHUNK) + t.shape[3:])
        return jnp.moveaxis(t, 2, 0)

    causal = jnp.tril(jnp.ones((ML_CHUNK, ML_CHUNK), dtype=bool))

    def step(carry, inp):
        c_st, n_st, m_st = carry
        qc, kc, vc, ic, fc = inp
        b = jnp.cumsum(fc, axis=-1)
        d_log = b[..., :, None] - b[..., None, :] + ic[..., None, :]
        d_log = jnp.where(causal, d_log, -jnp.inf)
        inter = b + m_st[..., None]
        m_t = jnp.maximum(inter, jnp.max(d_log, axis=-1))
        p = jnp.exp(d_log - m_t[..., None])
        sc = jnp.einsum('bhtd,bhsd->bhts', qc, kc) * p
        a = jnp.exp(inter - m_t)
        num = a[..., None] * jnp.einsum('bhvd,bhtd->bhtv', c_st, qc) + jnp.einsum('bhts,bhsv->bhtv', sc, vc)
        den = a * jnp.einsum('bhd,bhtd->bht', n_st, qc) + jnp.sum(sc, axis=-1)
        hc = num / jnp.maximum(jnp.abs(den), jnp.exp(-m_t))[..., None]
        b_last = b[..., -1]
        w_log = b_last[..., None] - b + ic
        m_new = jnp.maximum(b_last + m_st, jnp.max(w_log, axis=-1))
        decay = jnp.exp(b_last + m_st - m_new)
        w = jnp.exp(w_log - m_new[..., None])
        c_new = decay[..., None, None] * c_st + jnp.einsum('bhs,bhsv,bhsd->bhvd', w, vc, kc)
        n_new = decay[..., None] * n_st + jnp.einsum('bhs,bhsd->bhd', w, kc)
        return (c_new, n_new, m_new), hc

    init = (jnp.zeros((bsz, nh, dv, dk), jnp.float32),
            jnp.zeros((bsz, nh, dk), jnp.float32),
            jnp.zeros((bsz, nh), jnp.float32))
    _, hs = lax.scan(step, init, (to_chunks(q), to_chunks(k), to_chunks(v), to_chunks(ig), to_chunks(logf)))
    return jnp.moveaxis(hs, 0, 2).reshape(bsz, nh, s, dv)


def mlstm_mixer(h, w_in, b_i, b_f, norm_g, w_out):
    bsz, s, _ = h.shape
    proj = h @ w_in
    q, k, v, o, ig, fg = jnp.split(
        proj, [ML_QK_W, 2 * ML_QK_W, 2 * ML_QK_W + ML_V_W, 2 * ML_QK_W + 2 * ML_V_W,
               2 * ML_QK_W + 2 * ML_V_W + ML_HEADS], axis=-1)

    def heads(t, d):
        return t.reshape(bsz, s, ML_HEADS, d).transpose(0, 2, 1, 3).astype(jnp.float32)

    qh = heads(q, ML_QK_DIM) * (ML_QK_DIM ** -0.5)
    kh = heads(k, ML_QK_DIM)
    vh = heads(v, ML_V_DIM)
    i_pre = softcap((ig + b_i).astype(jnp.float32)).transpose(0, 2, 1)
    logf = jax.nn.log_sigmoid(softcap((fg + b_f).astype(jnp.float32))).transpose(0, 2, 1)
    hh = mlstm_chunkwise(qh, kh, vh, i_pre, logf)
    hh = hh * lax.rsqrt(jnp.mean(hh * hh, axis=-1, keepdims=True) + EPS)
    hh = hh.transpose(0, 2, 1, 3).reshape(bsz, s, ML_V_W) * norm_g.astype(jnp.float32)
    y = (hh * jax.nn.sigmoid(o.astype(jnp.float32))).astype(h.dtype)
    return y @ w_out


def conv_ffn(h, w_up, conv_w, conv_b, w_down):
    u = causal_dwconv(h @ w_up, conv_w) + conv_b
    g, val = jnp.split(u, 2, axis=-1)
    return (jax.nn.silu(g) * val) @ w_down


def setup_inputs(seed: int = 0) -> dict:
    key = jax.random.key(seed)
    ks = jax.random.split(key, 24)
    n_sc = (DEPTH + 1) // 2
    n_ml = DEPTH // 2
    d = D_MODEL
    f32 = jnp.float32
    nrm = lambda k, shape, s: jax.random.normal(k, shape, f32) * s
    return {
        "x": nrm(ks[0], (BATCH, SEQ, d), 1.0),
        "c": nrm(ks[1], (BATCH, d), 1.0),
        "ada_w": nrm(ks[2], (DEPTH, d, 6 * d), 0.2 * d ** -0.5),
        "ada_b": nrm(ks[3], (DEPTH, 6 * d), 0.02),
        "norm_mix_g": 1.0 + nrm(ks[4], (DEPTH, d), 0.05),
        "norm_ffn_g": 1.0 + nrm(ks[5], (DEPTH, d), 0.05),
        "sc_w_in": nrm(ks[6], (n_sc, d, 3 * d), d ** -0.5),
        "sc_conv_w": nrm(ks[7], (n_sc, CONV_WIDTH, d), CONV_WIDTH ** -0.5),
        "sc_w_out": nrm(ks[8], (n_sc, d, d), d ** -0.5),
        "ml_w_in": nrm(ks[9], (n_ml, d, ML_IN_W), d ** -0.5),
        "ml_b_i": nrm(ks[10], (n_ml, ML_HEADS), 0.1),
        "ml_b_f": jnp.linspace(3.0, 6.0, ML_HEADS, dtype=f32)[None, :] + nrm(ks[11], (n_ml, ML_HEADS), 0.1),
        "ml_norm_g": 1.0 + nrm(ks[12], (n_ml, ML_V_W), 0.05),
        "ml_w_out": nrm(ks[13], (n_ml, ML_V_W, d), ML_V_W ** -0.5),
        "ffn_w_up": nrm(ks[14], (DEPTH, d, 2 * D_FF), d ** -0.5),
        "ffn_conv_w": nrm(ks[15], (DEPTH, CONV_WIDTH, 2 * D_FF), CONV_WIDTH ** -0.5),
        "ffn_conv_b": nrm(ks[16], (DEPTH, 2 * D_FF), 0.02),
        "ffn_w_down": nrm(ks[17], (DEPTH, D_FF, d), D_FF ** -0.5),
        "final_norm_g": 1.0 + nrm(ks[18], (d,), 0.05),
    }


def reference(x, c, ada_w, ada_b, norm_mix_g, norm_ffn_g, sc_w_in, sc_conv_w, sc_w_out,
              ml_w_in, ml_b_i, ml_b_f, ml_norm_g, ml_w_out, ffn_w_up, ffn_conv_w, ffn_conv_b,
              ffn_w_down, final_norm_g):
    cond = jax.nn.silu(c)
    for layer in range(DEPTH):
        mod = cond @ ada_w[layer] + ada_b[layer]
        sh1, sc1, g1, sh2, sc2, g2 = jnp.split(mod, 6, axis=-1)
        h = modulate(rms_norm(x, norm_mix_g[layer]), sh1, sc1)
        j = layer // N_MIXERS
        if layer % N_MIXERS == 0:
            y = short_conv_mixer(h, sc_w_in[j], sc_conv_w[j], sc_w_out[j])
        else:
            y = mlstm_mixer(h, ml_w_in[j], ml_b_i[j], ml_b_f[j], ml_norm_g[j], ml_w_out[j])
        x = x + (1 + g1)[:, None, :] * y
        h = modulate(rms_norm(x, norm_ffn_g[layer]), sh2, sc2)
        x = x + (1 + g2)[:, None, :] * conv_ffn(h, ffn_w_up[layer], ffn_conv_w[layer], ffn_conv_b[layer], ffn_w_down[layer])
    return rms_norm(x, final_norm_g)
```

```cpp
#include <hip/hip_runtime.h>
#include <cstdio>
#include <cstdint>
namespace pg8 {
#define PG8_LAS __attribute__((address_space(3)))
typedef unsigned short bf16_t;
typedef short bf16x8 __attribute__((ext_vector_type(8)));
typedef float f32x4 __attribute__((ext_vector_type(4)));
typedef unsigned u32x4 __attribute__((ext_vector_type(4)));
constexpr int BM = 256, BK = 64, HALF = 128, HTB = HALF * BK * 2  , STAGE_BYTES = 8 * HTB, NXCD = 8, WGM = 8;

__host__ __device__ __forceinline__ int lds_byte(int r, int c) { const int st = (r >> 4) * 2 + (c >> 5), rr = r & 15, cc = c & 31, ob = rr * 64 + cc * 2; return st * 1024 + (ob ^ (((ob >> 9) & 1) << 5)); }
__host__ __device__ __forceinline__ void stage_rc(int b, int& R, int& C) { const int st = b / 1024, sb = b % 1024, swz = sb ^ (((sb >> 9) & 1) << 5); R = (st >> 1) * 16 + swz / 64; C = (st & 1) * 32 + (swz % 64) / 2; }
__host__ __device__ __forceinline__ int perm32(int rho) { const int n = rho >> 4, i = rho & 15; return 8 * (i >> 2) + 4 * n + (i & 3); }

struct Unit { int pm, pn; };
struct Gemm { const bf16_t* A; const bf16_t* Bt; int M, N, K; };

struct StaticOrder {
    int nM, nN, nwg, G, c;
    __host__ __device__ void init(int M, int N, int G_, int c_) { nM = M / BM; nN = N / BM; nwg = nM * nN; G = G_; c = c_; }
    __host__ __device__ bool next(int i, Unit& u) const {
        const long L = (long)i * G + c; if (L >= nwg) return false;
        int wgid = (int)L; { const int q = nwg / NXCD, r = nwg % NXCD, xcd = wgid % NXCD, off = wgid / NXCD; wgid = (xcd < r ? xcd * (q + 1) : r * (q + 1) + (xcd - r) * q) + off; }
        const int nig = WGM * nN, gid = wgid / nig, fm = gid * WGM, gsz = (nM - fm) < WGM ? (nM - fm) : WGM;
        u.pm = fm + ((wgid % nig) % gsz); u.pn = (wgid % nig) / gsz; return true;
    }
    __device__ __forceinline__ void a_ready(const Unit&) const {}
    __device__ __forceinline__ void done(const Unit&) const {}
};

__device__ __forceinline__ unsigned cvt_pk_bf16(float lo, float hi) { unsigned r; asm volatile("v_cvt_pk_bf16_f32 %0, %1, %2" : "=v"(r) : "v"(lo), "v"(hi)); return r; }
typedef float f32x2 __attribute__((ext_vector_type(2)));
__device__ __forceinline__ f32x2 gelu_pk(f32x2 v) {
    const f32x2 av = __builtin_elementwise_abs(v), d = av * 0.2316418882f + 1.0f;
    f32x2 t; t.x = __builtin_amdgcn_rcpf(d.x); t.y = __builtin_amdgcn_rcpf(d.y);
    f32x2 q = t * 0.5307027145f + (-0.7265760135f); q = q * t + 0.7107068705f; q = q * t + (-0.142248368f); q = q * t + 0.127414796f; q = q * t;
    const f32x2 s = (v * v) * (-0.72134752044f);
    f32x2 e; e.x = __builtin_amdgcn_exp2f(s.x); e.y = __builtin_amdgcn_exp2f(s.y);
    const f32x2 m = v * (q * e), r = v - m;
    f32x2 o; o.x = v.x < 0.f ? m.x : r.x; o.y = v.y < 0.f ? m.y : r.y; return o;
}

template <int ACT  > struct EpiBf16 {
    static constexpr bool PERM = true, AFTER_DRAIN = false; static_assert(ACT == 0 || ACT == 1, "EpiBf16: ACT is 0 (none) or 1 (gelu_pk)");
    bf16_t* O; int ldc; const float* bias; int split_cols; size_t split_stride; float scale0;
    __device__ __forceinline__ void operator()(const f32x4 (&acc)[2][2][4][2], const Unit& u, int wr, int wc, int fr, int fq) const {
        const int row0 = u.pm * BM + wr * 64 + fr; int colt = u.pn * BM; bf16_t* base = O;
        float sc = 1.f; if (split_cols) { const int t = colt / split_cols; base += (size_t)t * split_stride; colt -= t * split_cols; if (t == 0) sc = scale0; }
        const int col0 = colt + wc * 32 + 8 * fq, bcol0 = u.pn * BM + wc * 32 + 8 * fq;
        f32x4 bv[2][2];
#pragma unroll
        for (int bj = 0; bj < 2; ++bj)
#pragma unroll
            for (int n = 0; n < 2; ++n) bv[bj][n] = bias ? *(const f32x4*)(bias + bcol0 + bj * HALF + 4 * n) : (f32x4){0.f, 0.f, 0.f, 0.f};
#pragma unroll
        for (int ai = 0; ai < 2; ++ai)
#pragma unroll
            for (int m = 0; m < 4; ++m) { bf16_t* rowp = base + (size_t)(row0 + ai * HALF + m * 16) * ldc + col0;
#pragma unroll
                for (int bj = 0; bj < 2; ++bj) { f32x4 v0 = acc[ai][bj][m][0] + bv[bj][0], v1 = acc[ai][bj][m][1] + bv[bj][1];
                    if (ACT == 1) { f32x2 a = gelu_pk((f32x2){v0[0], v0[1]}), b = gelu_pk((f32x2){v0[2], v0[3]}), c = gelu_pk((f32x2){v1[0], v1[1]}), d = gelu_pk((f32x2){v1[2], v1[3]});
                        v0 = (f32x4){a.x, a.y, b.x, b.y}; v1 = (f32x4){c.x, c.y, d.x, d.y}; }
                    v0 = v0 * sc; v1 = v1 * sc; u32x4 w; w.x = cvt_pk_bf16(v0[0], v0[1]); w.y = cvt_pk_bf16(v0[2], v0[3]); w.z = cvt_pk_bf16(v1[0], v1[1]); w.w = cvt_pk_bf16(v1[2], v1[3]);
                    *(u32x4*)(rowp + bj * HALF) = w; } }
    }
};

struct EpiResid {
    static constexpr bool PERM = false, AFTER_DRAIN = false;
    const float* xin; float* xout; const float* gate;
    __device__ __forceinline__ void operator()(const f32x4 (&acc)[2][2][4][2], const Unit& u, int wr, int wc, int fr, int fq) const {
        const int row0 = u.pm * BM + wr * 64 + fr, col0 = u.pn * BM + wc * 32 + 4 * fq;
        const float* gp = gate + (size_t)(u.pm >> 3) * 6144 + col0;
        f32x4 gv[2][2];
#pragma unroll
        for (int bj = 0; bj < 2; ++bj)
#pragma unroll
            for (int n = 0; n < 2; ++n) gv[bj][n] = *(const f32x4*)(gp + bj * HALF + n * 16) + 1.0f;
#pragma unroll
        for (int ai = 0; ai < 2; ++ai)
#pragma unroll
            for (int m = 0; m < 4; ++m) { const size_t off = (size_t)(row0 + ai * HALF + m * 16) * 1024 + col0;
#pragma unroll
                for (int bj = 0; bj < 2; ++bj)
#pragma unroll
                    for (int n = 0; n < 2; ++n) { const f32x4 xi = *(const f32x4*)(xin + off + bj * HALF + n * 16);
                        *(f32x4*)(xout + off + bj * HALF + n * 16) = xi + gv[bj][n] * acc[ai][bj][m][n]; }
                if (m & 1) asm volatile("" ::: "memory"); }
    }
};


template <class Epi, class Sched, bool ALIGN_EPI = false, bool SP2 = false>
__device__ __forceinline__ void gemm_phase(PG8_LAS unsigned char* lds, const Gemm g, const Sched& S, const Epi& E, const int tid) {
    const int wid = __builtin_amdgcn_readfirstlane(tid >> 6), lane = tid & 63, wr = wid >> 2, wc = wid & 3, fr = lane & 15, fq = lane >> 4;
    const int K = g.K, nt = K / BK;
    unsigned voffA[2], voffB[2];
#pragma unroll
    for (int i = 0; i < 2; ++i) { int R, C; stage_rc(tid * 16 + i * 8192, R, C); const int Rb = Epi::PERM ? ((R & ~31) + perm32(R & 31)) : R;
        voffA[i] = (unsigned)(R * K + C) * 2u; voffB[i] = (unsigned)(Rb * K + C) * 2u; }
    const size_t kstep = (size_t)(BK * 2);
    const size_t hstep = (size_t)HALF * K * 2;
    const size_t tstep = 2 * hstep;
    const unsigned ldsw = (unsigned)wid * 1024u;
    const int aoff = lds_byte(wr * 64 + fr, fq * 8), boff = lds_byte(wc * 32 + fr, fq * 8);
#define PG8_SA(b, h) (((b) * 2 + (h)) * HTB)
#define PG8_SB(b, h) ((4 + (b) * 2 + (h)) * HTB)
#define PG8_STAGE(bufoff, gbase, voff) do { _Pragma("unroll") for (int _i = 0; _i < 2; ++_i) \
        __builtin_amdgcn_global_load_lds((const unsigned*)((const char*)(gbase) + (voff)[_i]), (PG8_LAS unsigned*)(lds + (bufoff) + ldsw + _i * 8192), 16, 0, 0); } while (0)
#define PG8_LDA(dst, b, h) do { _Pragma("unroll") for (int m = 0; m < 4; ++m) _Pragma("unroll") for (int k = 0; k < 2; ++k) dst[m][k] = *(const PG8_LAS bf16x8*)(lds + PG8_SA(b, h) + aoff + m * 2048 + k * 1024); } while (0)
#define PG8_LDB(dst, b, h) do { _Pragma("unroll") for (int n = 0; n < 2; ++n) _Pragma("unroll") for (int k = 0; k < 2; ++k) dst[n][k] = *(const PG8_LAS bf16x8*)(lds + PG8_SB(b, h) + boff + n * 2048 + k * 1024); } while (0)
#define PG8_MMA(ai, bj, At, Bt) do { __builtin_amdgcn_s_setprio(1); _Pragma("unroll") for (int m = 0; m < 4; ++m) _Pragma("unroll") for (int n = 0; n < 2; ++n) _Pragma("unroll") for (int k = 0; k < 2; ++k) \
        acc[ai][bj][m][n] = __builtin_amdgcn_mfma_f32_16x16x32_bf16(Bt[n][k], At[m][k], acc[ai][bj][m][n], 0, 0, 0); __builtin_amdgcn_s_setprio(0); } while (0)
#define PG8_WAIT_V(n) asm volatile("s_waitcnt vmcnt(" #n ")" ::: "memory")
#define PG8_WAIT_L(n) asm volatile("s_waitcnt lgkmcnt(" #n ")" ::: "memory")
#define PG8_BAR __builtin_amdgcn_s_barrier()
#define PG8_SCHED __builtin_amdgcn_sched_barrier(0)
    Unit cur, nxt; int ui = 0;
    if (!S.next(0, cur)) return;
    f32x4 acc[2][2][4][2];
#pragma unroll
    for (int a = 0; a < 2; ++a)
#pragma unroll
        for (int b = 0; b < 2; ++b)
#pragma unroll
            for (int m = 0; m < 4; ++m)
#pragma unroll
                for (int n = 0; n < 2; ++n) acc[a][b][m][n] = (f32x4){0.f, 0.f, 0.f, 0.f};
    bf16x8 At[4][2], B0[2][2], B1[2][2];
    const char* cA = (const char*)g.A + (size_t)cur.pm * tstep; const char* cB = (const char*)g.Bt + (size_t)cur.pn * tstep;
    S.a_ready(cur);
    if constexpr (SP2) {
        PG8_STAGE(PG8_SB(0, 0), cB, voffB); PG8_STAGE(PG8_SB(0, 1), cB + hstep, voffB); PG8_STAGE(PG8_SA(0, 0), cA, voffA); PG8_STAGE(PG8_SA(0, 1), cA + hstep, voffA);
        if (wr == 1) PG8_BAR;
        PG8_WAIT_V(2); PG8_BAR;
        PG8_STAGE(PG8_SB(1, 0), cB + kstep, voffB); PG8_STAGE(PG8_SA(1, 0), cA + kstep, voffA); PG8_STAGE(PG8_SB(1, 1), cB + hstep + kstep, voffB);
        PG8_WAIT_V(6); PG8_BAR;
    } else {
        PG8_STAGE(PG8_SB(0, 0), cB, voffB); PG8_STAGE(PG8_SA(0, 0), cA, voffA); PG8_STAGE(PG8_SB(0, 1), cB + hstep, voffB); PG8_STAGE(PG8_SA(0, 1), cA + hstep, voffA);
        if (wr == 1) PG8_BAR;
        PG8_WAIT_V(4); PG8_BAR;
        PG8_STAGE(PG8_SB(1, 0), cB + kstep, voffB); PG8_STAGE(PG8_SA(1, 0), cA + kstep, voffA); PG8_STAGE(PG8_SB(1, 1), cB + hstep + kstep, voffB);
        PG8_WAIT_V(6); PG8_BAR;
    }
    for (;;) {
        const bool has_next = S.next(ui + 1, nxt);
        const char* nA = has_next ? (const char*)g.A + (size_t)nxt.pm * tstep : cA; const char* nB = has_next ? (const char*)g.Bt + (size_t)nxt.pn * tstep : cB;
        for (int t = 0; t < nt; t += 2) {
            const bool last = (t == nt - 2);
            const char* a1 = cA + (size_t)(t + 1) * kstep;
            const char* a2 = last ? nA : cA + (size_t)(t + 2) * kstep; const char* b2 = last ? nB : cB + (size_t)(t + 2) * kstep;
            const char* a3 = a2 + kstep; const char* b3 = b2 + kstep;
            if (last && has_next) S.a_ready(nxt);
            if constexpr (SP2) {
            PG8_LDB(B0, 0, 0); PG8_LDB(B1, 0, 1); PG8_SCHED; PG8_LDA(At, 0, 0); PG8_STAGE(PG8_SA(1, 1), a1 + hstep, voffA);
            PG8_WAIT_V(8); PG8_WAIT_L(0); PG8_BAR; PG8_MMA(0, 0, At, B0); PG8_MMA(0, 1, At, B1); PG8_BAR; PG8_SCHED;
            PG8_LDA(At, 0, 1); PG8_STAGE(PG8_SB(0, 0), b2, voffB); PG8_STAGE(PG8_SB(0, 1), b2 + hstep, voffB); PG8_STAGE(PG8_SA(0, 0), a2, voffA);
            PG8_WAIT_V(8); PG8_WAIT_L(0); PG8_BAR; PG8_MMA(1, 0, At, B0); PG8_MMA(1, 1, At, B1); PG8_BAR; PG8_SCHED;
            PG8_LDB(B0, 1, 0); PG8_LDB(B1, 1, 1); PG8_SCHED; PG8_LDA(At, 1, 0); PG8_STAGE(PG8_SA(0, 1), a2 + hstep, voffA);
            PG8_WAIT_V(8); PG8_WAIT_L(0); PG8_BAR; PG8_MMA(0, 0, At, B0); PG8_MMA(0, 1, At, B1); PG8_BAR; PG8_SCHED;
            PG8_LDA(At, 1, 1); PG8_STAGE(PG8_SB(1, 0), b3, voffB); PG8_STAGE(PG8_SB(1, 1), b3 + hstep, voffB); PG8_STAGE(PG8_SA(1, 0), a3, voffA);
            PG8_WAIT_V(8); PG8_WAIT_L(0); PG8_BAR; PG8_MMA(1, 0, At, B0); PG8_MMA(1, 1, At, B1); PG8_BAR; PG8_SCHED;
            } else {
            PG8_LDB(B0, 0, 0); PG8_SCHED; PG8_LDA(At, 0, 0); PG8_STAGE(PG8_SA(1, 1), a1 + hstep, voffA);
            PG8_WAIT_L(8); PG8_BAR; PG8_WAIT_L(0); PG8_MMA(0, 0, At, B0); PG8_BAR; PG8_SCHED;
            PG8_LDB(B1, 0, 1); PG8_STAGE(PG8_SB(0, 0), b2, voffB);
            PG8_BAR; PG8_WAIT_L(0); PG8_MMA(0, 1, At, B1); PG8_BAR;
            PG8_LDA(At, 0, 1); PG8_STAGE(PG8_SA(0, 0), a2, voffA);
            PG8_BAR; PG8_WAIT_L(0); PG8_MMA(1, 0, At, B0); PG8_BAR; PG8_SCHED;
            PG8_STAGE(PG8_SB(0, 1), b2 + hstep, voffB);
            PG8_WAIT_V(6); PG8_BAR; PG8_MMA(1, 1, At, B1); PG8_BAR;
            PG8_LDB(B0, 1, 0); PG8_SCHED; PG8_LDA(At, 1, 0); PG8_STAGE(PG8_SA(0, 1), a2 + hstep, voffA);
            PG8_WAIT_L(8); PG8_BAR; PG8_WAIT_L(0); PG8_MMA(0, 0, At, B0); PG8_BAR; PG8_SCHED;
            PG8_LDB(B1, 1, 1); PG8_STAGE(PG8_SB(1, 0), b3, voffB);
            PG8_BAR; PG8_WAIT_L(0); PG8_MMA(0, 1, At, B1); PG8_BAR;
            PG8_LDA(At, 1, 1); PG8_STAGE(PG8_SA(1, 0), a3, voffA);
            PG8_BAR; PG8_WAIT_L(0); PG8_MMA(1, 0, At, B0); PG8_BAR; PG8_SCHED;
            PG8_STAGE(PG8_SB(1, 1), b3 + hstep, voffB);
            PG8_WAIT_V(6); PG8_BAR; PG8_MMA(1, 1, At, B1); PG8_BAR;
            }
        }
        if constexpr (ALIGN_EPI) { if (wr == 0) PG8_BAR; }
        if constexpr (!Epi::AFTER_DRAIN) { E(acc, cur, wr, wc, fr, fq); S.done(cur); }
        if (!has_next) break;
#pragma unroll
        for (int a = 0; a < 2; ++a)
#pragma unroll
            for (int b = 0; b < 2; ++b)
#pragma unroll
                for (int m = 0; m < 4; ++m)
#pragma unroll
                    for (int n = 0; n < 2; ++n) acc[a][b][m][n] = (f32x4){0.f, 0.f, 0.f, 0.f};
        cur = nxt; cA = nA; cB = nB; ++ui;
        if constexpr (ALIGN_EPI) { if (wr == 1) PG8_BAR; }
    }
    PG8_WAIT_V(0);
    if constexpr (!ALIGN_EPI) { if (wr == 0) PG8_BAR; }
    PG8_BAR;
    if constexpr (Epi::AFTER_DRAIN) { E.fused(acc, cur, wr, wc, fr, fq, lds, wid, lane); S.done(cur); }
#undef PG8_SA
#undef PG8_SB
#undef PG8_STAGE
#undef PG8_LDA
#undef PG8_LDB
#undef PG8_MMA
#undef PG8_WAIT_V
#undef PG8_WAIT_L
#undef PG8_BAR
#undef PG8_SCHED
}
}

#ifndef PG8_SP2
#define PG8_SP2 true
#endif
#ifndef PG8_ALIGN
#define PG8_ALIGN true
#endif

constexpr int NWAVES = 8;
constexpr int BATCH = 8, SEQ = 2048, D = 1024, M = BATCH * SEQ, DFF = 2816, NUP = 2 * DFF, NIN = 3072, MLW = 3080, DEPTH = 4;
constexpr float EPS = 1e-6f;
#ifndef MK_SEPARATE
#define MK_SEPARATE 0
#endif

constexpr size_t MiB = 1u << 20;
constexpr size_t WS_CTL = 0, CTL_ZERO_BYTES = 1 * MiB;
constexpr size_t WS_MOD = 1 * MiB;
constexpr size_t WS_IF = 2 * MiB;
constexpr size_t WS_WB = 4 * MiB;
constexpr size_t WB_IN = 0, WB_OUT = 6 * MiB, WB_UP = 8 * MiB, WB_DOWN = 19 * MiB, WB_LAYER = 24 * MiB + MiB / 2;
constexpr size_t WS_BIG = 102 * MiB;
constexpr size_t WS_P = WS_BIG, WS_Z = WS_BIG + 96 * MiB, WS_HH = WS_BIG + 128 * MiB;
constexpr size_t WS_HB = 278 * MiB;
constexpr size_t WS_XN = WS_HB;
constexpr size_t WS_END = 366 * MiB;
static_assert(WS_WB + 4 * WB_LAYER <= WS_BIG && WS_BIG + (size_t)M * NUP * 2 <= WS_HB && WS_HB + (size_t)M * DFF * 2 <= WS_END, "d_ws map");
constexpr int CW_BAR = 4096;

constexpr int RING_OFF = 0, RING_BYTES = 131072;
constexpr int LDSCTL_OFF = RING_BYTES, MISC_OFF = LDSCTL_OFF + 320;
constexpr int LDS_BYTES = 147456;

#define GAS __attribute__((address_space(1)))
#define LAS __attribute__((address_space(3)))
typedef unsigned short bf16;
typedef unsigned v4u __attribute__((ext_vector_type(4)));
typedef float f32x4 __attribute__((ext_vector_type(4)));
typedef short bf16x8 __attribute__((ext_vector_type(8)));
typedef GAS unsigned gu32;
typedef GAS unsigned long long gu64;
#define RLX_AGENT __ATOMIC_RELAXED, __HIP_MEMORY_SCOPE_AGENT
#define LDS_WAIT() asm volatile("s_waitcnt lgkmcnt(0)" ::: "memory")
#define VM_WAIT() asm volatile("s_waitcnt vmcnt(0)" ::: "memory")
__device__ __forceinline__ unsigned long long rt() { return __builtin_amdgcn_s_memrealtime(); }
__device__ __forceinline__ unsigned f2bf(float f) { unsigned u = __builtin_bit_cast(unsigned, f); return (u + 0x7fffu + ((u >> 16) & 1u)) >> 16; }
__device__ __forceinline__ unsigned pk2(float lo, float hi) { return f2bf(lo) | (f2bf(hi) << 16); }

#define XB_TMO      128
#define XB_XCNT(j)  (256  + 64 * (j))
#define XB_XSUB(j)  (1280 + 64 * (j))
#define XB_XGEN(j)  (2304 + 64 * (j))
#define XB_TOP      3328
#define XB_TOPGEN   3392
#define XCD_BAR_WORDS 3456
#define XB_SPIN_CAP (1u << 18)

__device__ __forceinline__ unsigned xb_ld(unsigned* p)              { return __hip_atomic_load(p, __ATOMIC_RELAXED, __HIP_MEMORY_SCOPE_AGENT); }
__device__ __forceinline__ unsigned xb_add(unsigned* p, unsigned v) { return __hip_atomic_fetch_add(p, v, __ATOMIC_RELAXED, __HIP_MEMORY_SCOPE_AGENT); }
__device__ __forceinline__ unsigned xb_xcc_id() { return (unsigned)__builtin_amdgcn_s_getreg((3 << 11) | 20) & 0xFu; }
#define XB_SPIN(cond, bar) do { unsigned _sp = 0; while (cond) { __builtin_amdgcn_s_sleep(1); \
    if ((++_sp & 255u) == 0u) { if (xb_ld(&(bar)[XB_TMO])) break; if (_sp > XB_SPIN_CAP) { atomicAdd(&(bar)[XB_TMO], 1u); break; } } } } while (0)

struct XcdBarrier {
    unsigned* bar; unsigned x;
    volatile LAS unsigned* st;
};

__device__ __forceinline__ XcdBarrier xcd_barrier_post(unsigned* bar, volatile LAS unsigned* st) {
    XcdBarrier b; b.bar = bar; b.x = xb_xcc_id(); b.st = st;
    if (threadIdx.x == 0) (void)xb_add(&bar[XB_XCNT(b.x)], 1u);
    return b;
}
__device__ __forceinline__ void xcd_barrier_complete(unsigned* bar, unsigned x, unsigned& nloc, unsigned& nx) {
    const unsigned G = gridDim.x * gridDim.y * gridDim.z;
    unsigned sum, cnt, mine, sp = 0u;
    for (;;) {
        sum = 0u; cnt = 0u; mine = 0u;
#pragma unroll
        for (unsigned j = 0; j < 16; ++j) { const unsigned c = xb_ld(&bar[XB_XCNT(j)]); sum += c; cnt += (c > 0u) ? 1u : 0u; mine = (j == x) ? c : mine; }
        if (sum == G) break;
        __builtin_amdgcn_s_sleep(1);
        if ((++sp & 255u) == 0u) { if (xb_ld(&bar[XB_TMO])) break; if (sp > XB_SPIN_CAP) { atomicAdd(&bar[XB_TMO], 1u); break; } }
    }
    nloc = mine > 0u ? mine : 1u; nx = cnt > 0u ? cnt : 1u;
}

__device__ __forceinline__ void xcd_barrier(const XcdBarrier& b) {
    asm volatile("s_waitcnt vmcnt(0)" ::: "memory");
    __syncthreads();
    if (threadIdx.x == 0) {
        unsigned* bar = b.bar;
        __builtin_amdgcn_s_waitcnt(0);
        unsigned nloc = b.st[0], nx = b.st[1];
        if (nloc == 0u) { xcd_barrier_complete(bar, b.x, nloc, nx); b.st[0] = nloc; b.st[1] = nx; }
        const unsigned old = xb_add(&bar[XB_XSUB(b.x)], 1u);
        const unsigned gen = old / nloc;
        if (old + 1u == (gen + 1u) * nloc) {
            __builtin_amdgcn_fence(__ATOMIC_RELEASE, "agent");
            asm volatile("s_waitcnt vmcnt(0)" ::: "memory");
            const unsigned og = xb_add(&bar[XB_TOP], 1u);
            const unsigned tg = og / nx;
            if (og + 1u == (tg + 1u) * nx) xb_add(&bar[XB_TOPGEN], 1u);
            else XB_SPIN(xb_ld(&bar[XB_TOPGEN]) == tg, bar);
            __builtin_amdgcn_fence(__ATOMIC_ACQUIRE, "agent");
            xb_add(&bar[XB_XGEN(b.x)], 1u);
            asm volatile("s_waitcnt vmcnt(0)" ::: "memory");
        } else {
            XB_SPIN(xb_ld(&bar[XB_XGEN(b.x)]) == gen, bar);
            __builtin_amdgcn_fence(__ATOMIC_ACQUIRE, "agent");
            asm volatile("s_waitcnt vmcnt(0)" ::: "memory");
        }
    }
    __syncthreads();
}


typedef unsigned v2u __attribute__((ext_vector_type(2)));
__device__ __forceinline__ float bflo(unsigned u) { return __builtin_bit_cast(float, u << 16); }
__device__ __forceinline__ float bfhi(unsigned u) { return __builtin_bit_cast(float, u & 0xffff0000u); }
__device__ __forceinline__ float wave_sum(float v) {
#pragma unroll
    for (int o = 1; o < 64; o <<= 1) v += __shfl_xor(v, o);
    return v;
}
__device__ __forceinline__ void unpack8(const v4u v, float (&f)[8]) {
    f[0] = bflo(v.x); f[1] = bfhi(v.x); f[2] = bflo(v.y); f[3] = bfhi(v.y); f[4] = bflo(v.z); f[5] = bfhi(v.z); f[6] = bflo(v.w); f[7] = bfhi(v.w);
}
__device__ __forceinline__ v4u pack8(const float (&f)[8]) { v4u o; o.x = pk2(f[0], f[1]); o.y = pk2(f[2], f[3]); o.z = pk2(f[4], f[5]); o.w = pk2(f[6], f[7]); return o; }
__device__ __forceinline__ float sigmoidf_(float x) { return 1.0f / (1.0f + __expf(-x)); }
__device__ __forceinline__ float softcap15(float t) { return 15.0f * tanhf(t * (1.0f / 15.0f)); }

struct Args { const float* in[19]; float* out; unsigned char* ws; int ph_lo, ph_hi; };
#define CAS __attribute__((address_space(4)))
typedef const CAS Args* ArgsP;
enum { I_X = 0, I_C, I_ADA_W, I_ADA_B, I_NORM_MIX_G, I_NORM_FFN_G, I_SC_W_IN, I_SC_CONV_W, I_SC_W_OUT, I_ML_W_IN, I_ML_B_I, I_ML_B_F, I_ML_NORM_G, I_ML_W_OUT, I_FFN_W_UP, I_FFN_CONV_W, I_FFN_CONV_B, I_FFN_W_DOWN, I_FINAL_NORM_G };
struct Ctx { LAS unsigned char* lds; int tid, lane, wave, bid, vcu, G; ArgsP a; unsigned char* ws; };
__device__ __forceinline__ Ctx mkctx(LAS unsigned char* lds_base) {
    Ctx c; int t = threadIdx.x; asm volatile("" : "+v"(t)); c.tid = t; c.lane = t & 63; c.wave = __builtin_amdgcn_readfirstlane(t >> 6);
    int b = blockIdx.x; asm volatile("" : "+s"(b)); c.bid = b; c.G = gridDim.x; c.vcu = (b & 7) * (c.G >> 3) + (b >> 3);
    ArgsP p = (ArgsP)__builtin_amdgcn_kernarg_segment_ptr(); asm volatile("" : "+s"(p)); c.a = p; c.ws = p->ws;
    c.lds = lds_base;
    return c;
}
#define F_IN(i) (F.a->in[i])
#define F_MOD ((float*)(F.ws + WS_MOD))
#define F_IFG ((float*)(F.ws + WS_IF))
#define F_P ((bf16*)(F.ws + WS_P))
#define F_Z ((bf16*)(F.ws + WS_Z))
#define F_HH ((bf16*)(F.ws + WS_HH))
#define F_U ((bf16*)(F.ws + WS_BIG))
#define F_HB ((bf16*)(F.ws + WS_HB))
#define F_XN ((bf16*)(F.ws + WS_XN))
__device__ __forceinline__ bf16* wb_ptr(const Ctx& F, int l, size_t off) { return (bf16*)(F.ws + WS_WB + (size_t)l * WB_LAYER + off); }

__device__ __forceinline__ void p0_transpose_item(const float* W, int ldw, int K, bf16* WT, LAS float* scr, int kb, int nb, int qrows, float qscale, int lane) {
    const int k0 = 64 * kb, n0 = 32 * nb;
#pragma unroll 8
    for (int i = 0; i < 32; ++i) { const int kk = 2 * i + (lane >> 5); scr[kk * 33 + (lane & 31)] = W[(size_t)(k0 + kk) * ldw + n0 + (lane & 31)]; }
    LDS_WAIT(); asm volatile("" ::: "memory");
    const int c = lane & 7;
#pragma unroll
    for (int j = 0; j < 4; ++j) { const int n = (lane >> 3) + 8 * j; const LAS float* s = scr + (8 * c) * 33 + n; const float sc = (n0 + n) < qrows ? qscale : 1.0f;
        v4u o; o.x = pk2(s[0 * 33] * sc, s[1 * 33] * sc); o.y = pk2(s[2 * 33] * sc, s[3 * 33] * sc); o.z = pk2(s[4 * 33] * sc, s[5 * 33] * sc); o.w = pk2(s[6 * 33] * sc, s[7 * 33] * sc);
        *(v4u*)(WT + (size_t)(n0 + n) * K + k0 + 8 * c) = o; }
    LDS_WAIT(); asm volatile("" ::: "memory");
}
__device__ __forceinline__ void p0_prologue(const Ctx& F) {
    if (F.bid < 192) {
        LAS float* sc = (LAS float*)(F.lds + RING_OFF);
        LAS float* red = (LAS float*)(F.lds + RING_OFF + 32768);
        const float* cin = F_IN(I_C);
        for (int i = F.tid; i < 8192; i += 512) { const float v = cin[i]; sc[i] = v / (1.0f + __expf(-v)); }
        __syncthreads();
        const int it = blockIdx.x, l = it / 48, n0 = (it % 48) * 128, q = F.tid & 31, ks = F.tid >> 5;
        const float* wp = F_IN(I_ADA_W) + ((size_t)l * 1024 + ks * 64) * 6144 + n0 + 4 * q;
        f32x4 acc[8];
#pragma unroll
        for (int b = 0; b < 8; ++b) acc[b] = (f32x4){0.f, 0.f, 0.f, 0.f};
#pragma unroll 8
        for (int i = 0; i < 64; ++i) { const f32x4 w = *(const f32x4*)(wp + (size_t)i * 6144);
#pragma unroll
            for (int b = 0; b < 8; ++b) { const float s = sc[b * 1024 + ks * 64 + i]; acc[b] += w * s; } }
#pragma unroll
        for (int b = 0; b < 8; ++b) *(LAS f32x4*)(red + (ks * 8 + b) * 128 + 4 * q) = acc[b];
        __syncthreads();
        for (int o = F.tid; o < 1024; o += 512) { const int b = o >> 7, n = o & 127; float s = F_IN(I_ADA_B)[l * 6144 + n0 + n];
#pragma unroll
            for (int k = 0; k < 16; ++k) s += red[(k * 8 + b) * 128 + n];
            F_MOD[((size_t)l * 8 + b) * 6144 + n0 + n] = s; }
        __syncthreads();
    }
    LAS float* scr = (LAS float*)(F.lds + RING_OFF + F.wave * 16384);
    const int gw = F.bid * NWAVES + F.wave, NGW = F.G * NWAVES;
    constexpr int I_IN = 16 * 96, I_OUT = 16 * 32, I_UP = 16 * 176, I_DN = 44 * 32, I_LAYER = I_IN + I_OUT + I_UP + I_DN;
    for (int it = gw; it < DEPTH * I_LAYER; it += NGW) {
        const int l = it / I_LAYER, j = l >> 1; int r = it % I_LAYER; const bool ml = (l & 1) != 0;
        if (r < I_IN) { const float* W = ml ? F_IN(I_ML_W_IN) + (size_t)j * 1024 * MLW : F_IN(I_SC_W_IN) + (size_t)j * 1024 * NIN;
            p0_transpose_item(W, ml ? MLW : NIN, 1024, wb_ptr(F, l, WB_IN), scr, r / 96, r % 96, ml ? 512 : 0, 0.08838834764831845f, F.lane); continue; } r -= I_IN;
        if (r < I_OUT) { const float* W = (ml ? F_IN(I_ML_W_OUT) : F_IN(I_SC_W_OUT)) + (size_t)j * 1024 * 1024;
            p0_transpose_item(W, 1024, 1024, wb_ptr(F, l, WB_OUT), scr, r / 32, r % 32, 0, 1.f, F.lane); continue; } r -= I_OUT;
        if (r < I_UP) { p0_transpose_item(F_IN(I_FFN_W_UP) + (size_t)l * 1024 * NUP, NUP, 1024, wb_ptr(F, l, WB_UP), scr, r / 176, r % 176, 0, 1.f, F.lane); continue; } r -= I_UP;
        p0_transpose_item(F_IN(I_FFN_W_DOWN) + (size_t)l * DFF * 1024, 1024, DFF, wb_ptr(F, l, WB_DOWN), scr, r / 32, r % 32, 0, 1.f, F.lane);
    }
}

__device__ __forceinline__ void norm_phase(const Ctx& F, const float* xsrc, int l, int second, bool gates) {
    const float* ng = (second ? F_IN(I_NORM_FFN_G) : F_IN(I_NORM_MIX_G)) + l * 1024;
    const float* modl = F_MOD + (size_t)l * 8 * 6144;
    const int shoff = second ? 3072 : 0, scoff = shoff + 1024;
    LAS float* W8T = (LAS float*)(F.lds + RING_OFF);
    if (gates) {
        const float* w = F_IN(I_ML_W_IN) + (size_t)(l >> 1) * 1024 * MLW + 3072;
        for (int i = F.tid; i < 8192; i += 512) { const int k = i >> 3, g = i & 7; W8T[g * 1024 + k] = w[(size_t)k * MLW + g]; }
        __syncthreads();
    }
    const int r0 = F.bid * 64 + F.wave * 8;
    for (int rr = 0; rr < 8; ++rr) {
        const int row = r0 + rr, b = row >> 11;
        const f32x4* xr = (const f32x4*)(xsrc + (size_t)row * 1024) + F.lane;
        f32x4 v[4]; float ss = 0.f;
#pragma unroll
        for (int j = 0; j < 4; ++j) { v[j] = xr[64 * j]; ss += (v[j].x * v[j].x + v[j].y * v[j].y) + (v[j].z * v[j].z + v[j].w * v[j].w); }
        const float rstd = rsqrtf(wave_sum(ss) * (1.0f / 1024.0f) + EPS);
        const float* mb = modl + (size_t)b * 6144;
#pragma unroll
        for (int j = 0; j < 4; ++j) { const int col = 4 * F.lane + 256 * j;
            const f32x4 g4 = *(const f32x4*)(ng + col), sc4 = *(const f32x4*)(mb + scoff + col), sh4 = *(const f32x4*)(mb + shoff + col);
            v[j] = (v[j] * rstd) * g4 * (sc4 + 1.0f) + sh4;
            v2u o; o.x = pk2(v[j].x, v[j].y); o.y = pk2(v[j].z, v[j].w);
            *(v2u*)(F_XN + (size_t)row * 1024 + col) = o; }
        if (gates) {
#pragma unroll
            for (int g = 0; g < 8; ++g) { float p = 0.f;
#pragma unroll
                for (int j = 0; j < 4; ++j) { const f32x4 w4 = *(const LAS f32x4*)(W8T + g * 1024 + 4 * F.lane + 256 * j); p += (v[j].x * w4.x + v[j].y * w4.y) + (v[j].z * w4.z + v[j].w * w4.w); }
                p = wave_sum(p);
                if (F.lane == 0) F_IFG[(size_t)row * 8 + g] = p; }
        }
    }
    if (gates) __syncthreads();
}

__device__ __forceinline__ void sc_gate_phase(const Ctx& F, int l) {
    const float* cw = F_IN(I_SC_CONV_W) + (size_t)(l >> 1) * 3 * 1024;
    const int cg = F.tid & 127, rg = F.tid >> 7, c0 = 8 * cg;
    const int t0 = F.bid * 64 + 16 * rg;
    float w0[8], w1[8], w2[8];
#pragma unroll
    for (int e = 0; e < 8; ++e) { w0[e] = cw[c0 + e]; w1[e] = cw[1024 + c0 + e]; w2[e] = cw[2048 + c0 + e]; }
    float p1[8], p2[8];
    if ((t0 & (SEQ - 1)) == 0) {
#pragma unroll
        for (int e = 0; e < 8; ++e) { p1[e] = 0.f; p2[e] = 0.f; }
    } else {
        float a[8], b[8];
        unpack8(*(const v4u*)(F_P + (size_t)(t0 - 1) * NIN + 1024 + c0), a); unpack8(*(const v4u*)(F_P + (size_t)(t0 - 1) * NIN + 2048 + c0), b);
#pragma unroll
        for (int e = 0; e < 8; ++e) p1[e] = a[e] * b[e];
        unpack8(*(const v4u*)(F_P + (size_t)(t0 - 2) * NIN + 1024 + c0), a); unpack8(*(const v4u*)(F_P + (size_t)(t0 - 2) * NIN + 2048 + c0), b);
#pragma unroll
        for (int e = 0; e < 8; ++e) p2[e] = a[e] * b[e];
    }
#pragma unroll 4
    for (int i = 0; i < 16; ++i) {
        const size_t t = (size_t)(t0 + i);
        float gb[8], gc[8], u[8], z[8];
        unpack8(*(const v4u*)(F_P + t * NIN + c0), gb); unpack8(*(const v4u*)(F_P + t * NIN + 1024 + c0), gc); unpack8(*(const v4u*)(F_P + t * NIN + 2048 + c0), u);
#pragma unroll
        for (int e = 0; e < 8; ++e) { const float p = gc[e] * u[e]; z[e] = gb[e] * (w0[e] * p2[e] + w1[e] * p1[e] + w2[e] * p); p2[e] = p1[e]; p1[e] = p; }
        *(v4u*)(F_Z + t * 1024 + c0) = pack8(z);
    }
}

__device__ __forceinline__ void ffn_gate_phase(const Ctx& F, int l) {
    const float* cw = F_IN(I_FFN_CONV_W) + (size_t)l * 3 * NUP;
    const float* cb = F_IN(I_FFN_CONV_B) + (size_t)l * NUP;
    for (int it = F.tid; it < 352 * 4; it += 512) {
        const int cg = it % 352, rg = it / 352, c0 = 8 * cg;
        const int t0 = F.bid * 64 + 16 * rg;
        float g1[8], g2[8], v1[8], v2[8];
        if ((t0 & (SEQ - 1)) == 0) {
#pragma unroll
            for (int e = 0; e < 8; ++e) { g1[e] = 0.f; g2[e] = 0.f; v1[e] = 0.f; v2[e] = 0.f; }
        } else {
            unpack8(*(const v4u*)(F_U + (size_t)(t0 - 1) * NUP + c0), g1); unpack8(*(const v4u*)(F_U + (size_t)(t0 - 1) * NUP + DFF + c0), v1);
            unpack8(*(const v4u*)(F_U + (size_t)(t0 - 2) * NUP + c0), g2); unpack8(*(const v4u*)(F_U + (size_t)(t0 - 2) * NUP + DFF + c0), v2);
        }
        for (int i = 0; i < 16; ++i) {
            const size_t t = (size_t)(t0 + i);
            float ug[8], uv[8], h[8];
            unpack8(*(const v4u*)(F_U + t * NUP + c0), ug); unpack8(*(const v4u*)(F_U + t * NUP + DFF + c0), uv);
#pragma unroll
            for (int e = 0; e < 8; ++e) {
                const float a = cw[c0 + e] * g2[e] + cw[NUP + c0 + e] * g1[e] + cw[2 * NUP + c0 + e] * ug[e] + cb[c0 + e];
                const float b = cw[DFF + c0 + e] * v2[e] + cw[NUP + DFF + c0 + e] * v1[e] + cw[2 * NUP + DFF + c0 + e] * uv[e] + cb[DFF + c0 + e];
                h[e] = a * sigmoidf_(a) * b; g2[e] = g1[e]; g1[e] = ug[e]; v2[e] = v1[e]; v1[e] = uv[e]; }
            *(v4u*)(F_HB + t * DFF + c0) = pack8(h);
        }
    }
}

__device__ __forceinline__ void ml_gate_phase(const Ctx& F, int l) {
    const float* ng = F_IN(I_ML_NORM_G) + (size_t)(l >> 1) * 1024;
    const int r0 = F.bid * 64 + F.wave * 8;
    for (int rr = 0; rr < 8; ++rr) {
        const size_t row = (size_t)(r0 + rr);
#pragma unroll
        for (int i = 0; i < 2; ++i) {
            const int c0 = 8 * F.lane + 512 * i;
            float hh[8], o[8], y[8];
            unpack8(*(const v4u*)(F_HH + row * 1024 + c0), hh); unpack8(*(const v4u*)(F_P + row * NIN + 2048 + c0), o);
            float ss = 0.f;
#pragma unroll
            for (int e = 0; e < 8; ++e) ss += hh[e] * hh[e];
#pragma unroll
            for (int s = 1; s < 32; s <<= 1) ss += __shfl_xor(ss, s);
            const float rstd = rsqrtf(ss * (1.0f / 256.0f) + EPS);
#pragma unroll
            for (int e = 0; e < 8; ++e) y[e] = hh[e] * rstd * ng[c0 + e] * sigmoidf_(o[e]);
            *(v4u*)(F_Z + row * 1024 + c0) = pack8(y);
        }
    }
}

__device__ __forceinline__ void final_norm_phase(const Ctx& F) {
    const int r0 = F.bid * 64 + F.wave * 8;
    for (int rr = 0; rr < 8; ++rr) {
        f32x4* xr = (f32x4*)(F.a->out + (size_t)(r0 + rr) * 1024) + F.lane;
        f32x4 v[4]; float ss = 0.f;
#pragma unroll
        for (int j = 0; j < 4; ++j) { v[j] = xr[64 * j]; ss += (v[j].x * v[j].x + v[j].y * v[j].y) + (v[j].z * v[j].z + v[j].w * v[j].w); }
        const float rstd = rsqrtf(wave_sum(ss) * (1.0f / 1024.0f) + EPS);
#pragma unroll
        for (int j = 0; j < 4; ++j) { const f32x4 g4 = *(const f32x4*)(F_IN(I_FINAL_NORM_G) + 4 * F.lane + 256 * j); xr[64 * j] = (v[j] * rstd) * g4; }
    }
}

constexpr int SQ_LD = 136, ST_LD = 72;
constexpr int L_QS = 0, L_KS = L_QS + 64 * SQ_LD * 2, L_KT = L_KS + 64 * SQ_LD * 2, L_VT = L_KT + 128 * ST_LD * 2, L_WVT = L_VT + 48 * ST_LD * 2, L_SC = L_WVT + 48 * ST_LD * 2,
              L_CB = L_SC + 64 * ST_LD * 2, L_VEC = L_CB + 48 * SQ_LD * 2, L_SCAN_END = L_VEC + 8 * 256;
static_assert(L_SCAN_END <= RING_BYTES && (L_KS % 16) == 0 && (L_KT % 16) == 0 && (L_VT % 16) == 0 && (L_WVT % 16) == 0 && (L_SC % 16) == 0 && (L_CB % 16) == 0 && (L_VEC % 16) == 0, "scan LDS map");
template <int K> __device__ __forceinline__ f32x4 mma_tile(const LAS bf16* A, int lda, const LAS bf16* B, int ldb, f32x4 acc, int lane) {
    const int r = lane & 15, kq = lane >> 4;
#pragma unroll
    for (int k0 = 0; k0 < K; k0 += 32) {
        const bf16x8 a = *(const LAS bf16x8*)(A + r * lda + k0 + 8 * kq);
        const bf16x8 b = *(const LAS bf16x8*)(B + r * ldb + k0 + 8 * kq);
        acc = __builtin_amdgcn_mfma_f32_16x16x32_bf16(a, b, acc, 0, 0, 0);
    }
    return acc;
}
__device__ __forceinline__ void scan_phase(const Ctx& F, int l) {
    const int j = l >> 1;
    const int item = F.vcu, bh = item >> 3, vs = item & 7, b = bh >> 2, h = bh & 3;
    const int tid = F.tid, lane = F.lane, wave = F.wave, r = lane & 15, kq = lane >> 4;
    LAS bf16* Qs = (LAS bf16*)(F.lds + L_QS); LAS bf16* Ks = (LAS bf16*)(F.lds + L_KS); LAS bf16* KT = (LAS bf16*)(F.lds + L_KT); LAS bf16* VT = (LAS bf16*)(F.lds + L_VT);
    LAS bf16* WVT = (LAS bf16*)(F.lds + L_WVT); LAS bf16* SC = (LAS bf16*)(F.lds + L_SC); LAS bf16* CB = (LAS bf16*)(F.lds + L_CB);
    LAS float* vBM = (LAS float*)(F.lds + L_VEC);
    LAS float* vG = vBM + 64;
    LAS float* vEM = vBM + 128;
    LAS float* vA = vBM + 192;
    LAS float* vW = vBM + 256;
    LAS float* vID = vBM + 320;
    LAS float* vS = vBM + 384;
    for (int i = tid; i < 16 * ST_LD; i += 512) VT[32 * ST_LD + i] = (i < ST_LD) ? (bf16)0x3F80 : (bf16)0;
    for (int i = tid; i < 48 * SQ_LD; i += 512) CB[i] = 0;
    f32x4 accC[3];
#pragma unroll
    for (int i = 0; i < 3; ++i) accC[i] = (f32x4){0.f, 0.f, 0.f, 0.f};
    float m_st = 0.f;
    const float b_i = F_IN(I_ML_B_I)[j * 4 + h], b_f = F_IN(I_ML_B_F)[j * 4 + h];
    const size_t tok0 = (size_t)b * SEQ;
    const int rho = tid >> 4, c16 = tid & 15;
    const int vrow = tid >> 2, c4 = tid & 3;
    v4u qreg[2], kreg[2], vreg; float gi = 0.f, gf = 0.f;
    vreg = (v4u){0u, 0u, 0u, 0u};
#define SCAN_LOAD(cc) do { const size_t tb_ = tok0 + (size_t)(cc) * 64; \
        _Pragma("unroll") for (int i_ = 0; i_ < 2; ++i_) { const bf16* p_ = F_P + (tb_ + rho + 32 * i_) * NIN + 128 * h + 8 * c16; qreg[i_] = *(const v4u*)p_; kreg[i_] = *(const v4u*)(p_ + 512); } \
        if (tid < 256) vreg = *(const v4u*)(F_P + (tb_ + vrow) * NIN + 1024 + 256 * h + 32 * vs + 8 * c4); \
        if (tid < 64) { gi = F_IFG[(tb_ + tid) * 8 + h]; gf = F_IFG[(tb_ + tid) * 8 + 4 + h]; } } while (0)
#define SCAN_STORE() do { \
        _Pragma("unroll") for (int i_ = 0; i_ < 2; ++i_) { const int row_ = rho + 32 * i_; *(LAS v4u*)(Qs + row_ * SQ_LD + 8 * c16) = qreg[i_]; *(LAS v4u*)(Ks + row_ * SQ_LD + 8 * c16) = kreg[i_]; \
            const unsigned kw_[4] = {kreg[i_].x, kreg[i_].y, kreg[i_].z, kreg[i_].w}; \
            _Pragma("unroll") for (int e_ = 0; e_ < 4; ++e_) { KT[(8 * c16 + 2 * e_) * ST_LD + row_] = (bf16)(kw_[e_] & 0xffffu); KT[(8 * c16 + 2 * e_ + 1) * ST_LD + row_] = (bf16)(kw_[e_] >> 16); } } \
        if (tid < 256) { const unsigned vw_[4] = {vreg.x, vreg.y, vreg.z, vreg.w}; \
            _Pragma("unroll") for (int e_ = 0; e_ < 4; ++e_) { VT[(8 * c4 + 2 * e_) * ST_LD + vrow] = (bf16)(vw_[e_] & 0xffffu); VT[(8 * c4 + 2 * e_ + 1) * ST_LD + vrow] = (bf16)(vw_[e_] >> 16); } } \
        if (wave == 0) { \
            const float ip_ = softcap15(gi + b_i); const float sf_ = softcap15(gf + b_f); const float lf_ = -log1pf(__expf(-sf_)); \
            float bc_ = lf_; \
            _Pragma("unroll") for (int o_ = 1; o_ < 64; o_ <<= 1) { const float t_ = __shfl_up(bc_, o_); if (lane >= o_) bc_ += t_; } \
            const float g_ = ip_ - bc_; float cm_ = g_; \
            _Pragma("unroll") for (int o_ = 1; o_ < 64; o_ <<= 1) { const float t_ = __shfl_up(cm_, o_); if (lane >= o_) cm_ = fmaxf(cm_, t_); } \
            const float mt_ = bc_ + fmaxf(m_st, cm_); \
            const float bL_ = __shfl(bc_, 63), mn_ = __shfl(mt_, 63); \
            vBM[lane] = bc_ - mt_; vG[lane] = g_; vEM[lane] = __expf(-mt_); vA[lane] = __expf(bc_ + m_st - mt_); vW[lane] = __expf(bL_ + g_ - mn_); \
            if (lane == 0) vS[0] = __expf(bL_ + m_st - mn_); \
            m_st = mn_; } } while (0)
    SCAN_LOAD(0);
    __syncthreads();
    SCAN_STORE();
    for (int cc = 0; cc < SEQ / 64; ++cc) {
        __syncthreads();
        if (cc + 1 < SEQ / 64) SCAN_LOAD(cc + 1);
        { const int tb = wave >> 1;
#pragma unroll
          for (int q = 0; q < 2; ++q) { const int sb = 2 * (wave & 1) + q;
              f32x4 s = (f32x4){0.f, 0.f, 0.f, 0.f};
              if (sb <= tb) s = mma_tile<128>(Qs + 16 * tb * SQ_LD, SQ_LD, Ks + 16 * sb * SQ_LD, SQ_LD, s, lane);
              const int sidx = 16 * sb + r; const float gs = vG[sidx];
#pragma unroll
              for (int e = 0; e < 4; ++e) { const int t = 16 * tb + 4 * kq + e; const float p = (sidx <= t) ? __expf(gs + vBM[t]) : 0.f; SC[t * ST_LD + sidx] = (bf16)f2bf(s[e] * p); } } }
#pragma unroll
        for (int i = 0; i < 6; ++i) { const int idx = tid + 512 * i, v = idx >> 6, s = idx & 63; WVT[v * ST_LD + s] = (bf16)f2bf(bflo((unsigned)VT[v * ST_LD + s]) * vW[s]); }
        __syncthreads();
        f32x4 num[2];
        { const int tb = wave & 3, nvb = (wave < 4) ? 2 : 1, vb0 = (wave < 4) ? 0 : 2;
#pragma unroll
          for (int q = 0; q < 2; ++q) if (q < nvb) { const int vb = vb0 + q;
              f32x4 a = mma_tile<128>(Qs + 16 * tb * SQ_LD, SQ_LD, CB + 16 * vb * SQ_LD, SQ_LD, (f32x4){0.f, 0.f, 0.f, 0.f}, lane);
#pragma unroll
              for (int e = 0; e < 4; ++e) a[e] *= vA[16 * tb + 4 * kq + e];
              num[q] = mma_tile<64>(SC + 16 * tb * ST_LD, ST_LD, VT + 16 * vb * ST_LD, ST_LD, a, lane); }
          if (wave >= 4 && r == 0) {
#pragma unroll
              for (int e = 0; e < 4; ++e) { const int t = 16 * tb + 4 * kq + e; vID[t] = 1.0f / fmaxf(fabsf(num[0][e]), vEM[t]); } } }
        __syncthreads();
        if (wave < 4) { const int tb = wave & 3;
#pragma unroll
            for (int q = 0; q < 2; ++q)
#pragma unroll
                for (int e = 0; e < 4; ++e) { const int t = 16 * tb + 4 * kq + e;
                    F_HH[(tok0 + (size_t)cc * 64 + t) * 1024 + 256 * h + 32 * vs + 16 * q + r] = (bf16)f2bf(num[q][e] * vID[t]); } }
        { const float decay = vS[0];
#pragma unroll
          for (int vb = 0; vb < 3; ++vb) { accC[vb] = accC[vb] * decay;
              accC[vb] = mma_tile<64>(WVT + 16 * vb * ST_LD, ST_LD, KT + 16 * wave * ST_LD, ST_LD, accC[vb], lane);
#pragma unroll
              for (int e = 0; e < 4; ++e) CB[(16 * vb + 4 * kq + e) * SQ_LD + 16 * wave + r] = (bf16)f2bf(accC[vb][e]); } }
        __syncthreads();
        if (cc + 1 < SEQ / 64) SCAN_STORE();
    }
#undef SCAN_LOAD
#undef SCAN_STORE
    __syncthreads();
}

constexpr int NPHASES = 2 + 9 * DEPTH;
__global__ void __launch_bounds__(NWAVES * 64, 2) mk_fwd(Args args) {
    extern __shared__ __attribute__((aligned(16))) unsigned char lds[];
    LAS unsigned char* L = (LAS unsigned char*)lds;
    volatile LAS unsigned* MISC = (volatile LAS unsigned*)(L + MISC_OFF);
    for (int u = threadIdx.x; u < (LDS_BYTES - LDSCTL_OFF) / 4; u += NWAVES * 64) ((LAS unsigned*)(L + LDSCTL_OFF))[u] = 0u;
    __syncthreads();
    const int lo = args.ph_lo, hi = args.ph_hi;
    XcdBarrier bar; bar.bar = (unsigned*)(args.ws + WS_CTL) + CW_BAR; bar.x = 0; bar.st = nullptr;
    if (hi - lo > 1) bar = xcd_barrier_post((unsigned*)(args.ws + WS_CTL) + CW_BAR, MISC + 8);

    for (int ph = lo; ph < hi; ++ph) {
        bool empty = false;
        const Ctx F = mkctx(L);
        if (ph == 0) { p0_prologue(F); }
        else if (ph == NPHASES - 1) { final_norm_phase(F); }
        else {
            const int l = (ph - 1) / 9, s = (ph - 1) % 9; const bool ml = (l & 1) != 0;
            if (s == 0) norm_phase(F, l == 0 ? F_IN(I_X) : (const float*)F.a->out, l, 0, ml);
            else if (s == 5) norm_phase(F, F.a->out, l, 1, false);
            else if (s == 1 || s == 6) {
                const bool up = (s == 6);
                pg8::Gemm g{F_XN, wb_ptr(F, l, up ? WB_UP : WB_IN), M, up ? NUP : NIN, 1024};
                pg8::StaticOrder S; S.init(M, g.N, F.G, F.bid);
                pg8::EpiBf16<0> E{up ? F_U : F_P, g.N, nullptr, 0, 0, 1.f};
                pg8::gemm_phase<pg8::EpiBf16<0>, pg8::StaticOrder, PG8_ALIGN, PG8_SP2>(F.lds + RING_OFF, g, S, E, F.tid);
            }
            else if (s == 4 || s == 8) {
                const bool dn = (s == 8);
                pg8::Gemm g{dn ? F_HB : F_Z, wb_ptr(F, l, dn ? WB_DOWN : WB_OUT), M, 1024, dn ? DFF : 1024};
                pg8::StaticOrder S; S.init(M, 1024, F.G, F.bid);
                pg8::EpiResid E{(l == 0 && !dn) ? F_IN(I_X) : (const float*)F.a->out, F.a->out, F_MOD + (size_t)l * 8 * 6144 + (dn ? 5120 : 2048)};
                pg8::gemm_phase<pg8::EpiResid, pg8::StaticOrder, PG8_ALIGN, PG8_SP2>(F.lds + RING_OFF, g, S, E, F.tid);
            }
            else if (s == 2) { if (ml) scan_phase(F, l); else sc_gate_phase(F, l); }
            else if (s == 3) { if (ml) ml_gate_phase(F, l); else empty = true; }
            else ffn_gate_phase(F, l);
        }
        if (!empty && ph + 1 < hi) xcd_barrier(bar);
    }
}

extern "C" void kernel_launch(void* const* d_in, const int* in_sizes, int n_in, void* d_out, int out_size, void* d_ws, size_t ws_size, hipStream_t stream) {
    static int grid = 0;
    if (grid == 0) {
        if (n_in != 19 || in_sizes[0] != M * D || out_size != M * D || ws_size < WS_END) { fprintf(stderr, "kernel_launch: unexpected shapes (n_in %d, in0 %d, out %d, ws %zu < %zu); nothing launched\n", n_in, n_in > 0 ? in_sizes[0] : -1, out_size, ws_size, (size_t)WS_END); grid = -1; return; }
        int dev = 0, cus = 0, per_cu = 0;
        if (hipGetDevice(&dev) != hipSuccess || hipDeviceGetAttribute(&cus, hipDeviceAttributeMultiprocessorCount, dev) != hipSuccess) { grid = -1; return; }
        if (hipFuncSetAttribute((const void*)mk_fwd, hipFuncAttributeMaxDynamicSharedMemorySize, LDS_BYTES) != hipSuccess) { fprintf(stderr, "kernel_launch: hipFuncSetAttribute failed\n"); grid = -1; return; }
        if (hipOccupancyMaxActiveBlocksPerMultiprocessor(&per_cu, (const void*)mk_fwd, NWAVES * 64, LDS_BYTES) != hipSuccess || per_cu < 1) fprintf(stderr, "kernel_launch: occupancy query reports %d\n", per_cu);
        (void)hipGetLastError();
        grid = cus;
        if (grid != 256) { fprintf(stderr, "kernel_launch: built for 256 CUs, device has %d; nothing launched\n", grid); grid = -1; return; }
    }
    if (grid < 0) return;
    if (hipMemsetAsync((char*)d_ws + WS_CTL, 0, CTL_ZERO_BYTES, stream) != hipSuccess) return;
    Args a{};
    for (int i = 0; i < 19; ++i) a.in[i] = (const float*)d_in[i];
    a.out = (float*)d_out; a.ws = (unsigned char*)d_ws;
#if MK_SEPARATE
    for (int ph = 0; ph < NPHASES; ++ph) {
        if (ph >= 1 && ph < NPHASES - 1 && ((ph - 1) % 9) == 3 && ((((ph - 1) / 9) & 1) == 0)) continue;
        a.ph_lo = ph; a.ph_hi = ph + 1;
        hipLaunchKernelGGL(mk_fwd, dim3(grid), dim3(NWAVES * 64), LDS_BYTES, stream, a);
    }
#else
    a.ph_lo = 0; a.ph_hi = NPHASES;
    hipLaunchKernelGGL(mk_fwd, dim3(grid), dim3(NWAVES * 64), LDS_BYTES, stream, a);
#endif
}
```

```cpp
#include <hip/hip_runtime.h>
#include <cstdio>
#include <cstdint>
namespace pg8 {
#define PG8_LAS __attribute__((address_space(3)))
typedef unsigned short bf16_t;
typedef short bf16x8 __attribute__((ext_vector_type(8)));
typedef float f32x4 __attribute__((ext_vector_type(4)));
typedef unsigned u32x4 __attribute__((ext_vector_type(4)));
constexpr int BM = 256, BK = 64, HALF = 128, HTB = HALF * BK * 2  , STAGE_BYTES = 8 * HTB, NXCD = 8, WGM = 8;

__host__ __device__ __forceinline__ int lds_byte(int r, int c) { const int st = (r >> 4) * 2 + (c >> 5), rr = r & 15, cc = c & 31, ob = rr * 64 + cc * 2; return st * 1024 + (ob ^ (((ob >> 9) & 1) << 5)); }
__host__ __device__ __forceinline__ void stage_rc(int b, int& R, int& C) { const int st = b / 1024, sb = b % 1024, swz = sb ^ (((sb >> 9) & 1) << 5); R = (st >> 1) * 16 + swz / 64; C = (st & 1) * 32 + (swz % 64) / 2; }
__host__ __device__ __forceinline__ int perm32(int rho) { const int n = rho >> 4, i = rho & 15; return 8 * (i >> 2) + 4 * n + (i & 3); }

struct Unit { int pm, pn; };
struct Gemm { const bf16_t* A; const bf16_t* Bt; int M, N, K; };

struct StaticOrder {
    int nM, nN, nwg, G, c;
    __host__ __device__ void init(int M, int N, int G_, int c_) { nM = M / BM; nN = N / BM; nwg = nM * nN; G = G_; c = c_; }
    __host__ __device__ bool next(int i, Unit& u) const {
        const long L = (long)i * G + c; if (L >= nwg) return false;
        int wgid = (int)L; { const int q = nwg / NXCD, r = nwg % NXCD, xcd = wgid % NXCD, off = wgid / NXCD; wgid = (xcd < r ? xcd * (q + 1) : r * (q + 1) + (xcd - r) * q) + off; }
        const int nig = WGM * nN, gid = wgid / nig, fm = gid * WGM, gsz = (nM - fm) < WGM ? (nM - fm) : WGM;
        u.pm = fm + ((wgid % nig) % gsz); u.pn = (wgid % nig) / gsz; return true;
    }
    __device__ __forceinline__ void a_ready(const Unit&) const {}
    __device__ __forceinline__ void done(const Unit&) const {}
};

__device__ __forceinline__ unsigned cvt_pk_bf16(float lo, float hi) { unsigned r; asm volatile("v_cvt_pk_bf16_f32 %0, %1, %2" : "=v"(r) : "v"(lo), "v"(hi)); return r; }
typedef float f32x2 __attribute__((ext_vector_type(2)));
__device__ __forceinline__ f32x2 gelu_pk(f32x2 v) {
    const f32x2 av = __builtin_elementwise_abs(v), d = av * 0.2316418882f + 1.0f;
    f32x2 t; t.x = __builtin_amdgcn_rcpf(d.x); t.y = __builtin_amdgcn_rcpf(d.y);
    f32x2 q = t * 0.5307027145f + (-0.7265760135f); q = q * t + 0.7107068705f; q = q * t + (-0.142248368f); q = q * t + 0.127414796f; q = q * t;
    const f32x2 s = (v * v) * (-0.72134752044f);
    f32x2 e; e.x = __builtin_amdgcn_exp2f(s.x); e.y = __builtin_amdgcn_exp2f(s.y);
    const f32x2 m = v * (q * e), r = v - m;
    f32x2 o; o.x = v.x < 0.f ? m.x : r.x; o.y = v.y < 0.f ? m.y : r.y; return o;
}

template <int ACT  > struct EpiBf16 {
    static constexpr bool PERM = true, AFTER_DRAIN = false, APERM = false; static_assert(ACT == 0 || ACT == 1, "EpiBf16: ACT is 0 (none) or 1 (gelu_pk)");
    bf16_t* O; int ldc; const float* bias; int split_cols; size_t split_stride; float scale0;
    __device__ __forceinline__ void operator()(const f32x4 (&acc)[2][2][4][2], const Unit& u, int wr, int wc, int fr, int fq) const {
        const int row0 = u.pm * BM + wr * 64 + fr; int colt = u.pn * BM; bf16_t* base = O;
        float sc = 1.f; if (split_cols) { const int t = colt / split_cols; base += (size_t)t * split_stride; colt -= t * split_cols; if (t == 0) sc = scale0; }
        const int col0 = colt + wc * 32 + 8 * fq, bcol0 = u.pn * BM + wc * 32 + 8 * fq;
        f32x4 bv[2][2];
#pragma unroll
        for (int bj = 0; bj < 2; ++bj)
#pragma unroll
            for (int n = 0; n < 2; ++n) bv[bj][n] = bias ? *(const f32x4*)(bias + bcol0 + bj * HALF + 4 * n) : (f32x4){0.f, 0.f, 0.f, 0.f};
#pragma unroll
        for (int ai = 0; ai < 2; ++ai)
#pragma unroll
            for (int m = 0; m < 4; ++m) { bf16_t* rowp = base + (size_t)(row0 + ai * HALF + m * 16) * ldc + col0;
#pragma unroll
                for (int bj = 0; bj < 2; ++bj) { f32x4 v0 = acc[ai][bj][m][0] + bv[bj][0], v1 = acc[ai][bj][m][1] + bv[bj][1];
                    if (ACT == 1) { f32x2 a = gelu_pk((f32x2){v0[0], v0[1]}), b = gelu_pk((f32x2){v0[2], v0[3]}), c = gelu_pk((f32x2){v1[0], v1[1]}), d = gelu_pk((f32x2){v1[2], v1[3]});
                        v0 = (f32x4){a.x, a.y, b.x, b.y}; v1 = (f32x4){c.x, c.y, d.x, d.y}; }
                    v0 = v0 * sc; v1 = v1 * sc; u32x4 w; w.x = cvt_pk_bf16(v0[0], v0[1]); w.y = cvt_pk_bf16(v0[2], v0[3]); w.z = cvt_pk_bf16(v1[0], v1[1]); w.w = cvt_pk_bf16(v1[2], v1[3]);
                    *(u32x4*)(rowp + bj * HALF) = w; } }
    }
};

struct EpiResid {
    static constexpr bool PERM = false, AFTER_DRAIN = false, APERM = false;
    const float* xin; float* xout; const float* gate;
    __device__ __forceinline__ void operator()(const f32x4 (&acc)[2][2][4][2], const Unit& u, int wr, int wc, int fr, int fq) const {
        const int row0 = u.pm * BM + wr * 64 + fr, col0 = u.pn * BM + wc * 32 + 4 * fq;
        const float* gp = gate + (size_t)(u.pm >> 3) * 6144 + col0;
        f32x4 gv[2][2];
#pragma unroll
        for (int bj = 0; bj < 2; ++bj)
#pragma unroll
            for (int n = 0; n < 2; ++n) gv[bj][n] = *(const f32x4*)(gp + bj * HALF + n * 16) + 1.0f;
#pragma unroll
        for (int ai = 0; ai < 2; ++ai)
#pragma unroll
            for (int m = 0; m < 4; ++m) { const size_t off = (size_t)(row0 + ai * HALF + m * 16) * 1024 + col0;
#pragma unroll
                for (int bj = 0; bj < 2; ++bj)
#pragma unroll
                    for (int n = 0; n < 2; ++n) { const f32x4 xi = *(const f32x4*)(xin + off + bj * HALF + n * 16);
                        *(f32x4*)(xout + off + bj * HALF + n * 16) = xi + gv[bj][n] * acc[ai][bj][m][n]; }
                if (m & 1) asm volatile("" ::: "memory"); }
    }
};


__device__ __forceinline__ f32x4 shfl4(const f32x4 v, int src) { f32x4 r; r.x = __shfl(v.x, src); r.y = __shfl(v.y, src); r.z = __shfl(v.z, src); r.w = __shfl(v.w, src); return r; }
__device__ __forceinline__ f32x4 silu_mul4(const f32x4 a, const f32x4 b) {
    f32x4 r;
    r.x = a.x * __builtin_amdgcn_rcpf(1.0f + __expf(-a.x)) * b.x; r.y = a.y * __builtin_amdgcn_rcpf(1.0f + __expf(-a.y)) * b.y;
    r.z = a.z * __builtin_amdgcn_rcpf(1.0f + __expf(-a.z)) * b.z; r.w = a.w * __builtin_amdgcn_rcpf(1.0f + __expf(-a.w)) * b.w; return r;
}
struct EpiFfn {
    static constexpr bool PERM = true, AFTER_DRAIN = false, APERM = true;
    bf16_t* HB; float* EDGE; const float* cw; const float* cb;
    __device__ __forceinline__ void operator()(const f32x4 (&acc)[2][2][4][2], const Unit& u, int wr, int wc, int fr, int fq) const {
        typedef unsigned u32x2 __attribute__((ext_vector_type(2)));
        const int lane = fq * 16 + fr, srcl = (lane - 1) & 63;
        const int ch0 = u.pn * 128 + wc * 32 + 8 * fq;
        const int rbase = u.pm * BM + wr * 128 + 8 * fr;
        const int blk = u.pm * 2 + wr;
        u32x2 hid0[8];
#pragma unroll
        for (int n = 0; n < 2; ++n) {
            const int c = ch0 + 4 * n;
            const f32x4 wg0 = *(const f32x4*)(cw + c), wg1 = *(const f32x4*)(cw + 5632 + c), wg2 = *(const f32x4*)(cw + 2 * 5632 + c), bg = *(const f32x4*)(cb + c);
            const f32x4 wv0 = *(const f32x4*)(cw + 2816 + c), wv1 = *(const f32x4*)(cw + 5632 + 2816 + c), wv2 = *(const f32x4*)(cw + 2 * 5632 + 2816 + c), bv = *(const f32x4*)(cb + 2816 + c);
            f32x4 p2g = shfl4(acc[1][0][2][n], srcl), p1g = shfl4(acc[1][0][3][n], srcl), p2v = shfl4(acc[1][1][2][n], srcl), p1v = shfl4(acc[1][1][3][n], srcl);
#pragma unroll
            for (int j = 0; j < 8; ++j) { const int ai = j >> 2, m = j & 3;
                const f32x4 cg = acc[ai][0][m][n], cv = acc[ai][1][m][n];
                const f32x4 a = wg0 * p2g + wg1 * p1g + wg2 * cg + bg, b = wv0 * p2v + wv1 * p1v + wv2 * cv + bv;
                const f32x4 hd = silu_mul4(a, b);
                u32x2 w; w.x = cvt_pk_bf16(hd[0], hd[1]); w.y = cvt_pk_bf16(hd[2], hd[3]);
                if (n == 0) hid0[j] = w;
                else if (!(fr == 0 && j < 2)) { u32x4 o; o.x = hid0[j].x; o.y = hid0[j].y; o.z = w.x; o.w = w.y; *(u32x4*)(HB + (size_t)(rbase + j) * 2816 + ch0) = o; }
                p2g = p1g; p1g = cg; p2v = p1v; p1v = cv; }
            if (fr == 0) { float* e0 = EDGE + (size_t)(blk * 4) * 5632 + c;
                *(f32x4*)(e0) = acc[0][0][0][n]; *(f32x4*)(e0 + 2816) = acc[0][1][0][n]; *(f32x4*)(e0 + 5632) = acc[0][0][1][n]; *(f32x4*)(e0 + 5632 + 2816) = acc[0][1][1][n]; }
            if (fr == 15) { float* e2 = EDGE + (size_t)(blk * 4 + 2) * 5632 + c;
                *(f32x4*)(e2) = acc[1][0][2][n]; *(f32x4*)(e2 + 2816) = acc[1][1][2][n]; *(f32x4*)(e2 + 5632) = acc[1][0][3][n]; *(f32x4*)(e2 + 5632 + 2816) = acc[1][1][3][n]; }
        }
    }
};


template <class Epi, class Sched, bool ALIGN_EPI = false, bool SP2 = false>
__device__ __forceinline__ void gemm_phase(PG8_LAS unsigned char* lds, const Gemm g, const Sched& S, const Epi& E, const int tid) {
    const int wid = __builtin_amdgcn_readfirstlane(tid >> 6), lane = tid & 63, wr = wid >> 2, wc = wid & 3, fr = lane & 15, fq = lane >> 4;
    const int K = g.K, nt = K / BK;
    unsigned voffA[2], voffB[2];
#pragma unroll
    for (int i = 0; i < 2; ++i) { int R, C; stage_rc(tid * 16 + i * 8192, R, C); const int Rb = Epi::PERM ? ((R & ~31) + perm32(R & 31)) : R;
        const int Ra = Epi::APERM ? (128 * (R >> 6) + 8 * (R & 15) + ((R >> 4) & 3)) : R;
        voffA[i] = (unsigned)(Ra * K + C) * 2u; voffB[i] = (unsigned)(Rb * K + C) * 2u; }
    const size_t kstep = (size_t)(BK * 2);
    const size_t hstep = (size_t)HALF * K * 2;
    const size_t hstepA = Epi::APERM ? (size_t)4 * K * 2 : hstep;
    const size_t tstep = 2 * hstep;
    const unsigned ldsw = (unsigned)wid * 1024u;
    const int aoff = lds_byte(wr * 64 + fr, fq * 8), boff = lds_byte(wc * 32 + fr, fq * 8);
#define PG8_SA(b, h) (((b) * 2 + (h)) * HTB)
#define PG8_SB(b, h) ((4 + (b) * 2 + (h)) * HTB)
#define PG8_STAGE(bufoff, gbase, voff) do { _Pragma("unroll") for (int _i = 0; _i < 2; ++_i) \
        __builtin_amdgcn_global_load_lds((const unsigned*)((const char*)(gbase) + (voff)[_i]), (PG8_LAS unsigned*)(lds + (bufoff) + ldsw + _i * 8192), 16, 0, 0); } while (0)
#define PG8_LDA(dst, b, h) do { _Pragma("unroll") for (int m = 0; m < 4; ++m) _Pragma("unroll") for (int k = 0; k < 2; ++k) dst[m][k] = *(const PG8_LAS bf16x8*)(lds + PG8_SA(b, h) + aoff + m * 2048 + k * 1024); } while (0)
#define PG8_LDB(dst, b, h) do { _Pragma("unroll") for (int n = 0; n < 2; ++n) _Pragma("unroll") for (int k = 0; k < 2; ++k) dst[n][k] = *(const PG8_LAS bf16x8*)(lds + PG8_SB(b, h) + boff + n * 2048 + k * 1024); } while (0)
#define PG8_MMA(ai, bj, At, Bt) do { __builtin_amdgcn_s_setprio(1); _Pragma("unroll") for (int m = 0; m < 4; ++m) _Pragma("unroll") for (int n = 0; n < 2; ++n) _Pragma("unroll") for (int k = 0; k < 2; ++k) \
        acc[ai][bj][m][n] = __builtin_amdgcn_mfma_f32_16x16x32_bf16(Bt[n][k], At[m][k], acc[ai][bj][m][n], 0, 0, 0); __builtin_amdgcn_s_setprio(0); } while (0)
#define PG8_WAIT_V(n) asm volatile("s_waitcnt vmcnt(" #n ")" ::: "memory")
#define PG8_WAIT_L(n) asm volatile("s_waitcnt lgkmcnt(" #n ")" ::: "memory")
#define PG8_BAR __builtin_amdgcn_s_barrier()
#define PG8_SCHED __builtin_amdgcn_sched_barrier(0)
    Unit cur, nxt; int ui = 0;
    if (!S.next(0, cur)) return;
    f32x4 acc[2][2][4][2];
#pragma unroll
    for (int a = 0; a < 2; ++a)
#pragma unroll
        for (int b = 0; b < 2; ++b)
#pragma unroll
            for (int m = 0; m < 4; ++m)
#pragma unroll
                for (int n = 0; n < 2; ++n) acc[a][b][m][n] = (f32x4){0.f, 0.f, 0.f, 0.f};
    bf16x8 At[4][2], B0[2][2], B1[2][2];
    const char* cA = (const char*)g.A + (size_t)cur.pm * tstep; const char* cB = (const char*)g.Bt + (size_t)cur.pn * tstep;
    S.a_ready(cur);
    if constexpr (SP2) {
        PG8_STAGE(PG8_SB(0, 0), cB, voffB); PG8_STAGE(PG8_SB(0, 1), cB + hstep, voffB); PG8_STAGE(PG8_SA(0, 0), cA, voffA); PG8_STAGE(PG8_SA(0, 1), cA + hstepA, voffA);
        if (wr == 1) PG8_BAR;
        PG8_WAIT_V(2); PG8_BAR;
        PG8_STAGE(PG8_SB(1, 0), cB + kstep, voffB); PG8_STAGE(PG8_SA(1, 0), cA + kstep, voffA); PG8_STAGE(PG8_SB(1, 1), cB + hstep + kstep, voffB);
        PG8_WAIT_V(6); PG8_BAR;
    } else {
        PG8_STAGE(PG8_SB(0, 0), cB, voffB); PG8_STAGE(PG8_SA(0, 0), cA, voffA); PG8_STAGE(PG8_SB(0, 1), cB + hstep, voffB); PG8_STAGE(PG8_SA(0, 1), cA + hstepA, voffA);
        if (wr == 1) PG8_BAR;
        PG8_WAIT_V(4); PG8_BAR;
        PG8_STAGE(PG8_SB(1, 0), cB + kstep, voffB); PG8_STAGE(PG8_SA(1, 0), cA + kstep, voffA); PG8_STAGE(PG8_SB(1, 1), cB + hstep + kstep, voffB);
        PG8_WAIT_V(6); PG8_BAR;
    }
    for (;;) {
        const bool has_next = S.next(ui + 1, nxt);
        const char* nA = has_next ? (const char*)g.A + (size_t)nxt.pm * tstep : cA; const char* nB = has_next ? (const char*)g.Bt + (size_t)nxt.pn * tstep : cB;
        for (int t = 0; t < nt; t += 2) {
            const bool last = (t == nt - 2);
            const char* a1 = cA + (size_t)(t + 1) * kstep;
            const char* a2 = last ? nA : cA + (size_t)(t + 2) * kstep; const char* b2 = last ? nB : cB + (size_t)(t + 2) * kstep;
            const char* a3 = a2 + kstep; const char* b3 = b2 + kstep;
            if (last && has_next) S.a_ready(nxt);
            if constexpr (SP2) {
            PG8_LDB(B0, 0, 0); PG8_LDB(B1, 0, 1); PG8_SCHED; PG8_LDA(At, 0, 0); PG8_STAGE(PG8_SA(1, 1), a1 + hstepA, voffA);
            PG8_WAIT_V(8); PG8_WAIT_L(0); PG8_BAR; PG8_MMA(0, 0, At, B0); PG8_MMA(0, 1, At, B1); PG8_BAR; PG8_SCHED;
            PG8_LDA(At, 0, 1); PG8_STAGE(PG8_SB(0, 0), b2, voffB); PG8_STAGE(PG8_SB(0, 1), b2 + hstep, voffB); PG8_STAGE(PG8_SA(0, 0), a2, voffA);
            PG8_WAIT_V(8); PG8_WAIT_L(0); PG8_BAR; PG8_MMA(1, 0, At, B0); PG8_MMA(1, 1, At, B1); PG8_BAR; PG8_SCHED;
            PG8_LDB(B0, 1, 0); PG8_LDB(B1, 1, 1); PG8_SCHED; PG8_LDA(At, 1, 0); PG8_STAGE(PG8_SA(0, 1), a2 + hstepA, voffA);
            PG8_WAIT_V(8); PG8_WAIT_L(0); PG8_BAR; PG8_MMA(0, 0, At, B0); PG8_MMA(0, 1, At, B1); PG8_BAR; PG8_SCHED;
            PG8_LDA(At, 1, 1); PG8_STAGE(PG8_SB(1, 0), b3, voffB); PG8_STAGE(PG8_SB(1, 1), b3 + hstep, voffB); PG8_STAGE(PG8_SA(1, 0), a3, voffA);
            PG8_WAIT_V(8); PG8_WAIT_L(0); PG8_BAR; PG8_MMA(1, 0, At, B0); PG8_MMA(1, 1, At, B1); PG8_BAR; PG8_SCHED;
            } else {
            PG8_LDB(B0, 0, 0); PG8_SCHED; PG8_LDA(At, 0, 0); PG8_STAGE(PG8_SA(1, 1), a1 + hstepA, voffA);
            PG8_WAIT_L(8); PG8_BAR; PG8_WAIT_L(0); PG8_MMA(0, 0, At, B0); PG8_BAR; PG8_SCHED;
            PG8_LDB(B1, 0, 1); PG8_STAGE(PG8_SB(0, 0), b2, voffB);
            PG8_BAR; PG8_WAIT_L(0); PG8_MMA(0, 1, At, B1); PG8_BAR;
            PG8_LDA(At, 0, 1); PG8_STAGE(PG8_SA(0, 0), a2, voffA);
            PG8_BAR; PG8_WAIT_L(0); PG8_MMA(1, 0, At, B0); PG8_BAR; PG8_SCHED;
            PG8_STAGE(PG8_SB(0, 1), b2 + hstep, voffB);
            PG8_WAIT_V(6); PG8_BAR; PG8_MMA(1, 1, At, B1); PG8_BAR;
            PG8_LDB(B0, 1, 0); PG8_SCHED; PG8_LDA(At, 1, 0); PG8_STAGE(PG8_SA(0, 1), a2 + hstepA, voffA);
            PG8_WAIT_L(8); PG8_BAR; PG8_WAIT_L(0); PG8_MMA(0, 0, At, B0); PG8_BAR; PG8_SCHED;
            PG8_LDB(B1, 1, 1); PG8_STAGE(PG8_SB(1, 0), b3, voffB);
            PG8_BAR; PG8_WAIT_L(0); PG8_MMA(0, 1, At, B1); PG8_BAR;
            PG8_LDA(At, 1, 1); PG8_STAGE(PG8_SA(1, 0), a3, voffA);
            PG8_BAR; PG8_WAIT_L(0); PG8_MMA(1, 0, At, B0); PG8_BAR; PG8_SCHED;
            PG8_STAGE(PG8_SB(1, 1), b3 + hstep, voffB);
            PG8_WAIT_V(6); PG8_BAR; PG8_MMA(1, 1, At, B1); PG8_BAR;
            }
        }
        if constexpr (ALIGN_EPI) { if (wr == 0) PG8_BAR; }
        if constexpr (!Epi::AFTER_DRAIN) { E(acc, cur, wr, wc, fr, fq); S.done(cur); }
        if (!has_next) break;
#pragma unroll
        for (int a = 0; a < 2; ++a)
#pragma unroll
            for (int b = 0; b < 2; ++b)
#pragma unroll
                for (int m = 0; m < 4; ++m)
#pragma unroll
                    for (int n = 0; n < 2; ++n) acc[a][b][m][n] = (f32x4){0.f, 0.f, 0.f, 0.f};
        cur = nxt; cA = nA; cB = nB; ++ui;
        if constexpr (ALIGN_EPI) { if (wr == 1) PG8_BAR; }
    }
    PG8_WAIT_V(0);
    if constexpr (!ALIGN_EPI) { if (wr == 0) PG8_BAR; }
    PG8_BAR;
    if constexpr (Epi::AFTER_DRAIN) { E.fused(acc, cur, wr, wc, fr, fq, lds, wid, lane); S.done(cur); }
#undef PG8_SA
#undef PG8_SB
#undef PG8_STAGE
#undef PG8_LDA
#undef PG8_LDB
#undef PG8_MMA
#undef PG8_WAIT_V
#undef PG8_WAIT_L
#undef PG8_BAR
#undef PG8_SCHED
}
}

#ifndef PG8_SP2
#define PG8_SP2 true
#endif
#ifndef PG8_ALIGN
#define PG8_ALIGN true
#endif

constexpr int NWAVES = 8;
constexpr int BATCH = 8, SEQ = 2048, D = 1024, M = BATCH * SEQ, DFF = 2816, NUP = 2 * DFF, NIN = 3072, MLW = 3080, DEPTH = 4;
constexpr float EPS = 1e-6f;
#ifndef MK_SEPARATE
#define MK_SEPARATE 0
#endif

constexpr size_t MiB = 1u << 20;
constexpr size_t WS_CTL = 0, CTL_ZERO_BYTES = 1 * MiB;
constexpr size_t WS_MOD = 1 * MiB;
constexpr size_t WS_IF = 2 * MiB;
constexpr size_t WS_WB = 4 * MiB;
constexpr size_t WB_IN = 0, WB_OUT = 6 * MiB, WB_UP = 8 * MiB, WB_DOWN = 19 * MiB, WB_LAYER = 24 * MiB + MiB / 2;
constexpr size_t WS_P = 102 * MiB;
constexpr size_t WS_EDGE = WS_P;
constexpr size_t WS_Z = 198 * MiB;
constexpr size_t WS_HH = 230 * MiB;
constexpr size_t WS_XN = 262 * MiB;
constexpr size_t WS_HB = 294 * MiB;
constexpr size_t WS_END = 382 * MiB;
static_assert(WS_WB + 4 * WB_LAYER <= WS_P && WS_HB + (size_t)M * DFF * 2 <= WS_END, "d_ws map");
constexpr int CW_BAR = 4096;

constexpr int RING_OFF = 0, RING_BYTES = 131072;
constexpr int LDSCTL_OFF = RING_BYTES, MISC_OFF = LDSCTL_OFF + 320;
constexpr int LDS_BYTES = 147456;

#define GAS __attribute__((address_space(1)))
#define LAS __attribute__((address_space(3)))
typedef unsigned short bf16;
typedef unsigned v4u __attribute__((ext_vector_type(4)));
typedef float f32x4 __attribute__((ext_vector_type(4)));
typedef short bf16x8 __attribute__((ext_vector_type(8)));
typedef GAS unsigned gu32;
typedef GAS unsigned long long gu64;
#define RLX_AGENT __ATOMIC_RELAXED, __HIP_MEMORY_SCOPE_AGENT
#define LDS_WAIT() asm volatile("s_waitcnt lgkmcnt(0)" ::: "memory")
#define VM_WAIT() asm volatile("s_waitcnt vmcnt(0)" ::: "memory")
__device__ __forceinline__ unsigned long long rt() { return __builtin_amdgcn_s_memrealtime(); }
__device__ __forceinline__ unsigned f2bf(float f) { unsigned u = __builtin_bit_cast(unsigned, f); return (u + 0x7fffu + ((u >> 16) & 1u)) >> 16; }
__device__ __forceinline__ unsigned pk2(float lo, float hi) { return f2bf(lo) | (f2bf(hi) << 16); }

#define XB_TMO      128
#define XB_XCNT(j)  (256  + 64 * (j))
#define XB_XSUB(j)  (1280 + 64 * (j))
#define XB_XGEN(j)  (2304 + 64 * (j))
#define XB_TOP      3328
#define XB_TOPGEN   3392
#define XCD_BAR_WORDS 3456
#define XB_SPIN_CAP (1u << 18)

__device__ __forceinline__ unsigned xb_ld(unsigned* p)              { return __hip_atomic_load(p, __ATOMIC_RELAXED, __HIP_MEMORY_SCOPE_AGENT); }
__device__ __forceinline__ unsigned xb_add(unsigned* p, unsigned v) { return __hip_atomic_fetch_add(p, v, __ATOMIC_RELAXED, __HIP_MEMORY_SCOPE_AGENT); }
__device__ __forceinline__ unsigned xb_xcc_id() { return (unsigned)__builtin_amdgcn_s_getreg((3 << 11) | 20) & 0xFu; }
#define XB_SPIN(cond, bar) do { unsigned _sp = 0; while (cond) { __builtin_amdgcn_s_sleep(1); \
    if ((++_sp & 255u) == 0u) { if (xb_ld(&(bar)[XB_TMO])) break; if (_sp > XB_SPIN_CAP) { atomicAdd(&(bar)[XB_TMO], 1u); break; } } } } while (0)

struct XcdBarrier {
    unsigned* bar; unsigned x;
    volatile LAS unsigned* st;
};

__device__ __forceinline__ XcdBarrier xcd_barrier_post(unsigned* bar, volatile LAS unsigned* st) {
    XcdBarrier b; b.bar = bar; b.x = xb_xcc_id(); b.st = st;
    if (threadIdx.x == 0) (void)xb_add(&bar[XB_XCNT(b.x)], 1u);
    return b;
}
__device__ __forceinline__ void xcd_barrier_complete(unsigned* bar, unsigned x, unsigned& nloc, unsigned& nx) {
    const unsigned G = gridDim.x * gridDim.y * gridDim.z;
    unsigned sum, cnt, mine, sp = 0u;
    for (;;) {
        sum = 0u; cnt = 0u; mine = 0u;
#pragma unroll
        for (unsigned j = 0; j < 16; ++j) { const unsigned c = xb_ld(&bar[XB_XCNT(j)]); sum += c; cnt += (c > 0u) ? 1u : 0u; mine = (j == x) ? c : mine; }
        if (sum == G) break;
        __builtin_amdgcn_s_sleep(1);
        if ((++sp & 255u) == 0u) { if (xb_ld(&bar[XB_TMO])) break; if (sp > XB_SPIN_CAP) { atomicAdd(&bar[XB_TMO], 1u); break; } }
    }
    nloc = mine > 0u ? mine : 1u; nx = cnt > 0u ? cnt : 1u;
}

__device__ __forceinline__ void xcd_barrier(const XcdBarrier& b) {
    asm volatile("s_waitcnt vmcnt(0)" ::: "memory");
    __syncthreads();
    if (threadIdx.x == 0) {
        unsigned* bar = b.bar;
        __builtin_amdgcn_s_waitcnt(0);
        unsigned nloc = b.st[0], nx = b.st[1];
        if (nloc == 0u) { xcd_barrier_complete(bar, b.x, nloc, nx); b.st[0] = nloc; b.st[1] = nx; }
        const unsigned old = xb_add(&bar[XB_XSUB(b.x)], 1u);
        const unsigned gen = old / nloc;
        if (old + 1u == (gen + 1u) * nloc) {
            __builtin_amdgcn_fence(__ATOMIC_RELEASE, "agent");
            asm volatile("s_waitcnt vmcnt(0)" ::: "memory");
            const unsigned og = xb_add(&bar[XB_TOP], 1u);
            const unsigned tg = og / nx;
            if (og + 1u == (tg + 1u) * nx) xb_add(&bar[XB_TOPGEN], 1u);
            else XB_SPIN(xb_ld(&bar[XB_TOPGEN]) == tg, bar);
            __builtin_amdgcn_fence(__ATOMIC_ACQUIRE, "agent");
            xb_add(&bar[XB_XGEN(b.x)], 1u);
            asm volatile("s_waitcnt vmcnt(0)" ::: "memory");
        } else {
            XB_SPIN(xb_ld(&bar[XB_XGEN(b.x)]) == gen, bar);
            __builtin_amdgcn_fence(__ATOMIC_ACQUIRE, "agent");
            asm volatile("s_waitcnt vmcnt(0)" ::: "memory");
        }
    }
    __syncthreads();
}


typedef unsigned v2u __attribute__((ext_vector_type(2)));
__device__ __forceinline__ float bflo(unsigned u) { return __builtin_bit_cast(float, u << 16); }
__device__ __forceinline__ float bfhi(unsigned u) { return __builtin_bit_cast(float, u & 0xffff0000u); }
__device__ __forceinline__ float wave_sum(float v) {
#pragma unroll
    for (int o = 1; o < 64; o <<= 1) v += __shfl_xor(v, o);
    return v;
}
__device__ __forceinline__ void unpack8(const v4u v, float (&f)[8]) {
    f[0] = bflo(v.x); f[1] = bfhi(v.x); f[2] = bflo(v.y); f[3] = bfhi(v.y); f[4] = bflo(v.z); f[5] = bfhi(v.z); f[6] = bflo(v.w); f[7] = bfhi(v.w);
}
__device__ __forceinline__ v4u pack8(const float (&f)[8]) { v4u o; o.x = pk2(f[0], f[1]); o.y = pk2(f[2], f[3]); o.z = pk2(f[4], f[5]); o.w = pk2(f[6], f[7]); return o; }
__device__ __forceinline__ float sigmoidf_(float x) { return 1.0f / (1.0f + __expf(-x)); }
__device__ __forceinline__ float softcap15(float t) { return 15.0f * tanhf(t * (1.0f / 15.0f)); }

struct Args { const float* in[19]; float* out; unsigned char* ws; int ph_lo, ph_hi; };
#define CAS __attribute__((address_space(4)))
typedef const CAS Args* ArgsP;
enum { I_X = 0, I_C, I_ADA_W, I_ADA_B, I_NORM_MIX_G, I_NORM_FFN_G, I_SC_W_IN, I_SC_CONV_W, I_SC_W_OUT, I_ML_W_IN, I_ML_B_I, I_ML_B_F, I_ML_NORM_G, I_ML_W_OUT, I_FFN_W_UP, I_FFN_CONV_W, I_FFN_CONV_B, I_FFN_W_DOWN, I_FINAL_NORM_G };
struct Ctx { LAS unsigned char* lds; int tid, lane, wave, bid, vcu, G; ArgsP a; unsigned char* ws; };
__device__ __forceinline__ Ctx mkctx(LAS unsigned char* lds_base) {
    Ctx c; int t = threadIdx.x; asm volatile("" : "+v"(t)); c.tid = t; c.lane = t & 63; c.wave = __builtin_amdgcn_readfirstlane(t >> 6);
    int b = blockIdx.x; asm volatile("" : "+s"(b)); c.bid = b; c.G = gridDim.x; c.vcu = (b & 7) * (c.G >> 3) + (b >> 3);
    ArgsP p = (ArgsP)__builtin_amdgcn_kernarg_segment_ptr(); asm volatile("" : "+s"(p)); c.a = p; c.ws = p->ws;
    c.lds = lds_base;
    return c;
}
#define F_IN(i) (F.a->in[i])
#define F_MOD ((float*)(F.ws + WS_MOD))
#define F_IFG ((float*)(F.ws + WS_IF))
#define F_P ((bf16*)(F.ws + WS_P))
#define F_Z ((bf16*)(F.ws + WS_Z))
#define F_HH ((bf16*)(F.ws + WS_HH))
#define F_HB ((bf16*)(F.ws + WS_HB))
#define F_XN ((bf16*)(F.ws + WS_XN))
__device__ __forceinline__ bf16* wb_ptr(const Ctx& F, int l, size_t off) { return (bf16*)(F.ws + WS_WB + (size_t)l * WB_LAYER + off); }

__device__ __forceinline__ void p0_transpose_item(const float* W, int ldw, int K, bf16* WT, LAS float* scr, int kb, int nb, int qrows, float qscale, int lane, int drow0 = -1) {
    const int k0 = 64 * kb, n0 = 32 * nb; if (drow0 < 0) drow0 = n0;
#pragma unroll 8
    for (int i = 0; i < 32; ++i) { const int kk = 2 * i + (lane >> 5); scr[kk * 33 + (lane & 31)] = W[(size_t)(k0 + kk) * ldw + n0 + (lane & 31)]; }
    LDS_WAIT(); asm volatile("" ::: "memory");
    const int c = lane & 7;
#pragma unroll
    for (int j = 0; j < 4; ++j) { const int n = (lane >> 3) + 8 * j; const LAS float* s = scr + (8 * c) * 33 + n; const float sc = (n0 + n) < qrows ? qscale : 1.0f;
        v4u o; o.x = pk2(s[0 * 33] * sc, s[1 * 33] * sc); o.y = pk2(s[2 * 33] * sc, s[3 * 33] * sc); o.z = pk2(s[4 * 33] * sc, s[5 * 33] * sc); o.w = pk2(s[6 * 33] * sc, s[7 * 33] * sc);
        *(v4u*)(WT + (size_t)(drow0 + n) * K + k0 + 8 * c) = o; }
    LDS_WAIT(); asm volatile("" ::: "memory");
}
__device__ __forceinline__ void p0_prologue(const Ctx& F) {
    if (F.bid < 192) {
        LAS float* sc = (LAS float*)(F.lds + RING_OFF);
        LAS float* red = (LAS float*)(F.lds + RING_OFF + 32768);
        const float* cin = F_IN(I_C);
        for (int i = F.tid; i < 8192; i += 512) { const float v = cin[i]; sc[i] = v / (1.0f + __expf(-v)); }
        __syncthreads();
        const int it = blockIdx.x, l = it / 48, n0 = (it % 48) * 128, q = F.tid & 31, ks = F.tid >> 5;
        const float* wp = F_IN(I_ADA_W) + ((size_t)l * 1024 + ks * 64) * 6144 + n0 + 4 * q;
        f32x4 acc[8];
#pragma unroll
        for (int b = 0; b < 8; ++b) acc[b] = (f32x4){0.f, 0.f, 0.f, 0.f};
#pragma unroll 8
        for (int i = 0; i < 64; ++i) { const f32x4 w = *(const f32x4*)(wp + (size_t)i * 6144);
#pragma unroll
            for (int b = 0; b < 8; ++b) { const float s = sc[b * 1024 + ks * 64 + i]; acc[b] += w * s; } }
#pragma unroll
        for (int b = 0; b < 8; ++b) *(LAS f32x4*)(red + (ks * 8 + b) * 128 + 4 * q) = acc[b];
        __syncthreads();
        for (int o = F.tid; o < 1024; o += 512) { const int b = o >> 7, n = o & 127; float s = F_IN(I_ADA_B)[l * 6144 + n0 + n];
#pragma unroll
            for (int k = 0; k < 16; ++k) s += red[(k * 8 + b) * 128 + n];
            F_MOD[((size_t)l * 8 + b) * 6144 + n0 + n] = s; }
        __syncthreads();
    }
    LAS float* scr = (LAS float*)(F.lds + RING_OFF + F.wave * 16384);
    const int gw = F.bid * NWAVES + F.wave, NGW = F.G * NWAVES;
    constexpr int I_IN = 16 * 96, I_OUT = 16 * 32, I_UP = 16 * 176, I_DN = 44 * 32, I_LAYER = I_IN + I_OUT + I_UP + I_DN;
    for (int it = gw; it < DEPTH * I_LAYER; it += NGW) {
        const int l = it / I_LAYER, j = l >> 1; int r = it % I_LAYER; const bool ml = (l & 1) != 0;
        if (r < I_IN) { const float* W = ml ? F_IN(I_ML_W_IN) + (size_t)j * 1024 * MLW : F_IN(I_SC_W_IN) + (size_t)j * 1024 * NIN;
            p0_transpose_item(W, ml ? MLW : NIN, 1024, wb_ptr(F, l, WB_IN), scr, r / 96, r % 96, ml ? 512 : 0, 0.08838834764831845f, F.lane); continue; } r -= I_IN;
        if (r < I_OUT) { const float* W = (ml ? F_IN(I_ML_W_OUT) : F_IN(I_SC_W_OUT)) + (size_t)j * 1024 * 1024;
            p0_transpose_item(W, 1024, 1024, wb_ptr(F, l, WB_OUT), scr, r / 32, r % 32, 0, 1.f, F.lane); continue; } r -= I_OUT;
        if (r < I_UP) { const int nb = r % 176, n0 = 32 * nb, nn = n0 < DFF ? n0 : n0 - DFF;
            p0_transpose_item(F_IN(I_FFN_W_UP) + (size_t)l * 1024 * NUP, NUP, 1024, wb_ptr(F, l, WB_UP), scr, r / 176, nb, 0, 1.f, F.lane, 256 * (nn >> 7) + (nn & 127) + (n0 < DFF ? 0 : 128)); continue; } r -= I_UP;
        p0_transpose_item(F_IN(I_FFN_W_DOWN) + (size_t)l * DFF * 1024, 1024, DFF, wb_ptr(F, l, WB_DOWN), scr, r / 32, r % 32, 0, 1.f, F.lane);
    }
}

__device__ __forceinline__ void norm_phase(const Ctx& F, const float* xsrc, int l, int second, bool gates) {
    const float* ng = (second ? F_IN(I_NORM_FFN_G) : F_IN(I_NORM_MIX_G)) + l * 1024;
    const float* modl = F_MOD + (size_t)l * 8 * 6144;
    const int shoff = second ? 3072 : 0, scoff = shoff + 1024;
    LAS float* W8T = (LAS float*)(F.lds + RING_OFF);
    if (gates) {
        const float* w = F_IN(I_ML_W_IN) + (size_t)(l >> 1) * 1024 * MLW + 3072;
        for (int i = F.tid; i < 8192; i += 512) { const int k = i >> 3, g = i & 7; W8T[g * 1024 + k] = w[(size_t)k * MLW + g]; }
        __syncthreads();
    }
    const int r0 = F.bid * 64 + F.wave * 8;
    for (int rr = 0; rr < 8; ++rr) {
        const int row = r0 + rr, b = row >> 11;
        const f32x4* xr = (const f32x4*)(xsrc + (size_t)row * 1024) + F.lane;
        f32x4 v[4]; float ss = 0.f;
#pragma unroll
        for (int j = 0; j < 4; ++j) { v[j] = xr[64 * j]; ss += (v[j].x * v[j].x + v[j].y * v[j].y) + (v[j].z * v[j].z + v[j].w * v[j].w); }
        const float rstd = rsqrtf(wave_sum(ss) * (1.0f / 1024.0f) + EPS);
        const float* mb = modl + (size_t)b * 6144;
#pragma unroll
        for (int j = 0; j < 4; ++j) { const int col = 4 * F.lane + 256 * j;
            const f32x4 g4 = *(const f32x4*)(ng + col), sc4 = *(const f32x4*)(mb + scoff + col), sh4 = *(const f32x4*)(mb + shoff + col);
            v[j] = (v[j] * rstd) * g4 * (sc4 + 1.0f) + sh4;
            v2u o; o.x = pk2(v[j].x, v[j].y); o.y = pk2(v[j].z, v[j].w);
            *(v2u*)(F_XN + (size_t)row * 1024 + col) = o; }
        if (gates) {
#pragma unroll
            for (int g = 0; g < 8; ++g) { float p = 0.f;
#pragma unroll
                for (int j = 0; j < 4; ++j) { const f32x4 w4 = *(const LAS f32x4*)(W8T + g * 1024 + 4 * F.lane + 256 * j); p += (v[j].x * w4.x + v[j].y * w4.y) + (v[j].z * w4.z + v[j].w * w4.w); }
                p = wave_sum(p);
                if (F.lane == 0) F_IFG[(size_t)row * 8 + g] = p; }
        }
    }
    if (gates) __syncthreads();
}

__device__ __forceinline__ void sc_gate_phase(const Ctx& F, int l) {
    const float* cw = F_IN(I_SC_CONV_W) + (size_t)(l >> 1) * 3 * 1024;
    const int cg = F.tid & 127, rg = F.tid >> 7, c0 = 8 * cg;
    const int t0 = F.bid * 64 + 16 * rg;
    float w0[8], w1[8], w2[8];
#pragma unroll
    for (int e = 0; e < 8; ++e) { w0[e] = cw[c0 + e]; w1[e] = cw[1024 + c0 + e]; w2[e] = cw[2048 + c0 + e]; }
    float p1[8], p2[8];
    if ((t0 & (SEQ - 1)) == 0) {
#pragma unroll
        for (int e = 0; e < 8; ++e) { p1[e] = 0.f; p2[e] = 0.f; }
    } else {
        float a[8], b[8];
        unpack8(*(const v4u*)(F_P + (size_t)(t0 - 1) * NIN + 1024 + c0), a); unpack8(*(const v4u*)(F_P + (size_t)(t0 - 1) * NIN + 2048 + c0), b);
#pragma unroll
        for (int e = 0; e < 8; ++e) p1[e] = a[e] * b[e];
        unpack8(*(const v4u*)(F_P + (size_t)(t0 - 2) * NIN + 1024 + c0), a); unpack8(*(const v4u*)(F_P + (size_t)(t0 - 2) * NIN + 2048 + c0), b);
#pragma unroll
        for (int e = 0; e < 8; ++e) p2[e] = a[e] * b[e];
    }
#pragma unroll 4
    for (int i = 0; i < 16; ++i) {
        const size_t t = (size_t)(t0 + i);
        float gb[8], gc[8], u[8], z[8];
        unpack8(*(const v4u*)(F_P + t * NIN + c0), gb); unpack8(*(const v4u*)(F_P + t * NIN + 1024 + c0), gc); unpack8(*(const v4u*)(F_P + t * NIN + 2048 + c0), u);
#pragma unroll
        for (int e = 0; e < 8; ++e) { const float p = gc[e] * u[e]; z[e] = gb[e] * (w0[e] * p2[e] + w1[e] * p1[e] + w2[e] * p); p2[e] = p1[e]; p1[e] = p; }
        *(v4u*)(F_Z + t * 1024 + c0) = pack8(z);
    }
}

__device__ __forceinline__ void ffn_fixup_phase(const Ctx& F, int l) {
    const float* cw = F_IN(I_FFN_CONV_W) + (size_t)l * 3 * NUP;
    const float* cb = F_IN(I_FFN_CONV_B) + (size_t)l * NUP;
    const float* EDGE = (const float*)(F.ws + WS_EDGE);
    const int blk = F.bid >> 1, i = F.bid & 1; const size_t t = (size_t)blk * 128 + i;
    const bool seq0 = ((blk * 128) & (SEQ - 1)) == 0;
    const float* E0 = EDGE + (size_t)(blk * 4) * NUP; const float* Em = EDGE + (size_t)((blk - 1) * 4) * NUP;
    for (int c = F.tid; c < DFF; c += 512) {
        float y[2];
#pragma unroll
        for (int part = 0; part < 2; ++part) { const int col = c + part * DFF;
            const float r0 = E0[col], r1 = E0[NUP + col], rm1 = seq0 ? 0.f : Em[3 * NUP + col], rm2 = seq0 ? 0.f : Em[2 * NUP + col];
            const float w0 = cw[col], w1 = cw[NUP + col], w2 = cw[2 * NUP + col];
            y[part] = (i == 0 ? (w0 * rm2 + w1 * rm1 + w2 * r0) : (w0 * rm1 + w1 * r0 + w2 * r1)) + cb[col]; }
        F_HB[t * DFF + c] = (bf16)f2bf(y[0] * sigmoidf_(y[0]) * y[1]);
    }
}

__device__ __forceinline__ void ml_gate_phase(const Ctx& F, int l) {
    const float* ng = F_IN(I_ML_NORM_G) + (size_t)(l >> 1) * 1024;
    const int r0 = F.bid * 64 + F.wave * 8;
    for (int rr = 0; rr < 8; ++rr) {
        const size_t row = (size_t)(r0 + rr);
#pragma unroll
        for (int i = 0; i < 2; ++i) {
            const int c0 = 8 * F.lane + 512 * i;
            float hh[8], o[8], y[8];
            unpack8(*(const v4u*)(F_HH + row * 1024 + c0), hh); unpack8(*(const v4u*)(F_P + row * NIN + 2048 + c0), o);
            float ss = 0.f;
#pragma unroll
            for (int e = 0; e < 8; ++e) ss += hh[e] * hh[e];
#pragma unroll
            for (int s = 1; s < 32; s <<= 1) ss += __shfl_xor(ss, s);
            const float rstd = rsqrtf(ss * (1.0f / 256.0f) + EPS);
#pragma unroll
            for (int e = 0; e < 8; ++e) y[e] = hh[e] * rstd * ng[c0 + e] * sigmoidf_(o[e]);
            *(v4u*)(F_Z + row * 1024 + c0) = pack8(y);
        }
    }
}

__device__ __forceinline__ void final_norm_phase(const Ctx& F) {
    const int r0 = F.bid * 64 + F.wave * 8;
    for (int rr = 0; rr < 8; ++rr) {
        f32x4* xr = (f32x4*)(F.a->out + (size_t)(r0 + rr) * 1024) + F.lane;
        f32x4 v[4]; float ss = 0.f;
#pragma unroll
        for (int j = 0; j < 4; ++j) { v[j] = xr[64 * j]; ss += (v[j].x * v[j].x + v[j].y * v[j].y) + (v[j].z * v[j].z + v[j].w * v[j].w); }
        const float rstd = rsqrtf(wave_sum(ss) * (1.0f / 1024.0f) + EPS);
#pragma unroll
        for (int j = 0; j < 4; ++j) { const f32x4 g4 = *(const f32x4*)(F_IN(I_FINAL_NORM_G) + 4 * F.lane + 256 * j); xr[64 * j] = (v[j] * rstd) * g4; }
    }
}

constexpr int SQ_LD = 136, ST_LD = 72;
constexpr int L_QS = 0, L_KS = L_QS + 64 * SQ_LD * 2, L_KT = L_KS + 64 * SQ_LD * 2, L_VT = L_KT + 128 * ST_LD * 2, L_WVT = L_VT + 48 * ST_LD * 2, L_SC = L_WVT + 48 * ST_LD * 2,
              L_CB = L_SC + 64 * ST_LD * 2, L_VEC = L_CB + 48 * SQ_LD * 2, L_SCAN_END = L_VEC + 8 * 256;
static_assert(L_SCAN_END <= RING_BYTES && (L_KS % 16) == 0 && (L_KT % 16) == 0 && (L_VT % 16) == 0 && (L_WVT % 16) == 0 && (L_SC % 16) == 0 && (L_CB % 16) == 0 && (L_VEC % 16) == 0, "scan LDS map");
template <int K> __device__ __forceinline__ f32x4 mma_tile(const LAS bf16* A, int lda, const LAS bf16* B, int ldb, f32x4 acc, int lane) {
    const int r = lane & 15, kq = lane >> 4;
#pragma unroll
    for (int k0 = 0; k0 < K; k0 += 32) {
        const bf16x8 a = *(const LAS bf16x8*)(A + r * lda + k0 + 8 * kq);
        const bf16x8 b = *(const LAS bf16x8*)(B + r * ldb + k0 + 8 * kq);
        acc = __builtin_amdgcn_mfma_f32_16x16x32_bf16(a, b, acc, 0, 0, 0);
    }
    return acc;
}
__device__ __forceinline__ void scan_phase(const Ctx& F, int l) {
    const int j = l >> 1;
    const int item = F.vcu, bh = item >> 3, vs = item & 7, b = bh >> 2, h = bh & 3;
    const int tid = F.tid, lane = F.lane, wave = F.wave, r = lane & 15, kq = lane >> 4;
    LAS bf16* Qs = (LAS bf16*)(F.lds + L_QS); LAS bf16* Ks = (LAS bf16*)(F.lds + L_KS); LAS bf16* KT = (LAS bf16*)(F.lds + L_KT); LAS bf16* VT = (LAS bf16*)(F.lds + L_VT);
    LAS bf16* WVT = (LAS bf16*)(F.lds + L_WVT); LAS bf16* SC = (LAS bf16*)(F.lds + L_SC); LAS bf16* CB = (LAS bf16*)(F.lds + L_CB);
    LAS float* vBM = (LAS float*)(F.lds + L_VEC);
    LAS float* vG = vBM + 64;
    LAS float* vEM = vBM + 128;
    LAS float* vA = vBM + 192;
    LAS float* vW = vBM + 256;
    LAS float* vID = vBM + 320;
    LAS float* vS = vBM + 384;
    for (int i = tid; i < 16 * ST_LD; i += 512) VT[32 * ST_LD + i] = (i < ST_LD) ? (bf16)0x3F80 : (bf16)0;
    for (int i = tid; i < 48 * SQ_LD; i += 512) CB[i] = 0;
    f32x4 accC[3];
#pragma unroll
    for (int i = 0; i < 3; ++i) accC[i] = (f32x4){0.f, 0.f, 0.f, 0.f};
    float m_st = 0.f;
    const float b_i = F_IN(I_ML_B_I)[j * 4 + h], b_f = F_IN(I_ML_B_F)[j * 4 + h];
    const size_t tok0 = (size_t)b * SEQ;
    const int rho = tid >> 4, c16 = tid & 15;
    const int vrow = tid >> 2, c4 = tid & 3;
    v4u qreg[2], kreg[2], vreg; float gi = 0.f, gf = 0.f;
    vreg = (v4u){0u, 0u, 0u, 0u};
#define SCAN_LOAD(cc) do { const size_t tb_ = tok0 + (size_t)(cc) * 64; \
        _Pragma("unroll") for (int i_ = 0; i_ < 2; ++i_) { const bf16* p_ = F_P + (tb_ + rho + 32 * i_) * NIN + 128 * h + 8 * c16; qreg[i_] = *(const v4u*)p_; kreg[i_] = *(const v4u*)(p_ + 512); } \
        if (tid < 256) vreg = *(const v4u*)(F_P + (tb_ + vrow) * NIN + 1024 + 256 * h + 32 * vs + 8 * c4); \
        if (tid < 64) { gi = F_IFG[(tb_ + tid) * 8 + h]; gf = F_IFG[(tb_ + tid) * 8 + 4 + h]; } } while (0)
#define SCAN_STORE() do { \
        _Pragma("unroll") for (int i_ = 0; i_ < 2; ++i_) { const int row_ = rho + 32 * i_; *(LAS v4u*)(Qs + row_ * SQ_LD + 8 * c16) = qreg[i_]; *(LAS v4u*)(Ks + row_ * SQ_LD + 8 * c16) = kreg[i_]; \
            const unsigned kw_[4] = {kreg[i_].x, kreg[i_].y, kreg[i_].z, kreg[i_].w}; \
            _Pragma("unroll") for (int e_ = 0; e_ < 4; ++e_) { KT[(8 * c16 + 2 * e_) * ST_LD + row_] = (bf16)(kw_[e_] & 0xffffu); KT[(8 * c16 + 2 * e_ + 1) * ST_LD + row_] = (bf16)(kw_[e_] >> 16); } } \
        if (tid < 256) { const unsigned vw_[4] = {vreg.x, vreg.y, vreg.z, vreg.w}; \
            _Pragma("unroll") for (int e_ = 0; e_ < 4; ++e_) { VT[(8 * c4 + 2 * e_) * ST_LD + vrow] = (bf16)(vw_[e_] & 0xffffu); VT[(8 * c4 + 2 * e_ + 1) * ST_LD + vrow] = (bf16)(vw_[e_] >> 16); } } \
        if (wave == 0) { \
            const float ip_ = softcap15(gi + b_i); const float sf_ = softcap15(gf + b_f); const float lf_ = -log1pf(__expf(-sf_)); \
            float bc_ = lf_; \
            _Pragma("unroll") for (int o_ = 1; o_ < 64; o_ <<= 1) { const float t_ = __shfl_up(bc_, o_); if (lane >= o_) bc_ += t_; } \
            const float g_ = ip_ - bc_; float cm_ = g_; \
            _Pragma("unroll") for (int o_ = 1; o_ < 64; o_ <<= 1) { const float t_ = __shfl_up(cm_, o_); if (lane >= o_) cm_ = fmaxf(cm_, t_); } \
            const float mt_ = bc_ + fmaxf(m_st, cm_); \
            const float bL_ = __shfl(bc_, 63), mn_ = __shfl(mt_, 63); \
            vBM[lane] = bc_ - mt_; vG[lane] = g_; vEM[lane] = __expf(-mt_); vA[lane] = __expf(bc_ + m_st - mt_); vW[lane] = __expf(bL_ + g_ - mn_); \
            if (lane == 0) vS[0] = __expf(bL_ + m_st - mn_); \
            m_st = mn_; } } while (0)
    SCAN_LOAD(0);
    __syncthreads();
    SCAN_STORE();
    for (int cc = 0; cc < SEQ / 64; ++cc) {
        __syncthreads();
        if (cc + 1 < SEQ / 64) SCAN_LOAD(cc + 1);
        { const int tb = wave >> 1;
#pragma unroll
          for (int q = 0; q < 2; ++q) { const int sb = 2 * (wave & 1) + q;
              f32x4 s = (f32x4){0.f, 0.f, 0.f, 0.f};
              if (sb <= tb) s = mma_tile<128>(Qs + 16 * tb * SQ_LD, SQ_LD, Ks + 16 * sb * SQ_LD, SQ_LD, s, lane);
              const int sidx = 16 * sb + r; const float gs = vG[sidx];
#pragma unroll
              for (int e = 0; e < 4; ++e) { const int t = 16 * tb + 4 * kq + e; const float p = (sidx <= t) ? __expf(gs + vBM[t]) : 0.f; SC[t * ST_LD + sidx] = (bf16)f2bf(s[e] * p); } } }
#pragma unroll
        for (int i = 0; i < 6; ++i) { const int idx = tid + 512 * i, v = idx >> 6, s = idx & 63; WVT[v * ST_LD + s] = (bf16)f2bf(bflo((unsigned)VT[v * ST_LD + s]) * vW[s]); }
        __syncthreads();
        f32x4 num[2];
        { const int tb = wave & 3, nvb = (wave < 4) ? 2 : 1, vb0 = (wave < 4) ? 0 : 2;
#pragma unroll
          for (int q = 0; q < 2; ++q) if (q < nvb) { const int vb = vb0 + q;
              f32x4 a = mma_tile<128>(Qs + 16 * tb * SQ_LD, SQ_LD, CB + 16 * vb * SQ_LD, SQ_LD, (f32x4){0.f, 0.f, 0.f, 0.f}, lane);
#pragma unroll
              for (int e = 0; e < 4; ++e) a[e] *= vA[16 * tb + 4 * kq + e];
              num[q] = mma_tile<64>(SC + 16 * tb * ST_LD, ST_LD, VT + 16 * vb * ST_LD, ST_LD, a, lane); }
          if (wave >= 4 && r == 0) {
#pragma unroll
              for (int e = 0; e < 4; ++e) { const int t = 16 * tb + 4 * kq + e; vID[t] = 1.0f / fmaxf(fabsf(num[0][e]), vEM[t]); } } }
        __syncthreads();
        if (wave < 4) { const int tb = wave & 3;
#pragma unroll
            for (int q = 0; q < 2; ++q)
#pragma unroll
                for (int e = 0; e < 4; ++e) { const int t = 16 * tb + 4 * kq + e;
                    F_HH[(tok0 + (size_t)cc * 64 + t) * 1024 + 256 * h + 32 * vs + 16 * q + r] = (bf16)f2bf(num[q][e] * vID[t]); } }
        { const float decay = vS[0];
#pragma unroll
          for (int vb = 0; vb < 3; ++vb) { accC[vb] = accC[vb] * decay;
              accC[vb] = mma_tile<64>(WVT + 16 * vb * ST_LD, ST_LD, KT + 16 * wave * ST_LD, ST_LD, accC[vb], lane);
#pragma unroll
              for (int e = 0; e < 4; ++e) CB[(16 * vb + 4 * kq + e) * SQ_LD + 16 * wave + r] = (bf16)f2bf(accC[vb][e]); } }
        __syncthreads();
        if (cc + 1 < SEQ / 64) SCAN_STORE();
    }
#undef SCAN_LOAD
#undef SCAN_STORE
    __syncthreads();
}

constexpr int NPHASES = 2 + 9 * DEPTH;
__global__ void __launch_bounds__(NWAVES * 64, 2) mk_fwd(Args args) {
    extern __shared__ __attribute__((aligned(16))) unsigned char lds[];
    LAS unsigned char* L = (LAS unsigned char*)lds;
    volatile LAS unsigned* MISC = (volatile LAS unsigned*)(L + MISC_OFF);
    for (int u = threadIdx.x; u < (LDS_BYTES - LDSCTL_OFF) / 4; u += NWAVES * 64) ((LAS unsigned*)(L + LDSCTL_OFF))[u] = 0u;
    __syncthreads();
    const int lo = args.ph_lo, hi = args.ph_hi;
    XcdBarrier bar; bar.bar = (unsigned*)(args.ws + WS_CTL) + CW_BAR; bar.x = 0; bar.st = nullptr;
    if (hi - lo > 1) bar = xcd_barrier_post((unsigned*)(args.ws + WS_CTL) + CW_BAR, MISC + 8);

#ifndef PROBE_REPEAT
#define PROBE_REPEAT 0
#endif
    for (int ph = lo; ph < hi; ++ph) {
      int kind;
      if (ph == 0) kind = 0; else if (ph == NPHASES - 1) kind = 8; else { const int s_ = (ph - 1) % 9, l_ = (ph - 1) / 9;
          kind = (s_ == 0 || s_ == 5) ? 1 : s_ == 1 ? 2 : s_ == 6 ? 3 : s_ == 2 ? ((l_ & 1) ? 5 : 4) : s_ == 3 ? ((l_ & 1) ? 6 : 9) : s_ == 7 ? 7 : 9; }
      const int nrep = 1 + ((PROBE_REPEAT >> kind) & 1);
      for (int rep = 0; rep < nrep; ++rep) {
        if (rep) xcd_barrier(bar);
        if ((PROBE_REPEAT >> 10) & 1) xcd_barrier(bar);
        bool empty = false;
        const Ctx F = mkctx(L);
        if (ph == 0) { p0_prologue(F); }
        else if (ph == NPHASES - 1) { final_norm_phase(F); }
        else {
            const int l = (ph - 1) / 9, s = (ph - 1) % 9; const bool ml = (l & 1) != 0;
            if (s == 0) norm_phase(F, l == 0 ? F_IN(I_X) : (const float*)F.a->out, l, 0, ml);
            else if (s == 5) norm_phase(F, F.a->out, l, 1, false);
            else if (s == 1) {
                pg8::Gemm g{F_XN, wb_ptr(F, l, WB_IN), M, NIN, 1024};
                pg8::StaticOrder S; S.init(M, NIN, F.G, F.bid);
                pg8::EpiBf16<0> E{F_P, NIN, nullptr, 0, 0, 1.f};
                pg8::gemm_phase<pg8::EpiBf16<0>, pg8::StaticOrder, PG8_ALIGN, PG8_SP2>(F.lds + RING_OFF, g, S, E, F.tid);
            }
            else if (s == 6) {
                pg8::Gemm g{F_XN, wb_ptr(F, l, WB_UP), M, NUP, 1024};
                pg8::StaticOrder S; S.init(M, NUP, F.G, F.bid);
                pg8::EpiFfn E{F_HB, (float*)(F.ws + WS_EDGE), F_IN(I_FFN_CONV_W) + (size_t)l * 3 * NUP, F_IN(I_FFN_CONV_B) + (size_t)l * NUP};
                pg8::gemm_phase<pg8::EpiFfn, pg8::StaticOrder, PG8_ALIGN, PG8_SP2>(F.lds + RING_OFF, g, S, E, F.tid);
            }
            else if (s == 4 || s == 8) {
                const bool dn = (s == 8);
                pg8::Gemm g{dn ? F_HB : F_Z, wb_ptr(F, l, dn ? WB_DOWN : WB_OUT), M, 1024, dn ? DFF : 1024};
                pg8::StaticOrder S; S.init(M, 1024, F.G, F.bid);
                pg8::EpiResid E{(l == 0 && !dn) ? F_IN(I_X) : (const float*)F.a->out, F.a->out, F_MOD + (size_t)l * 8 * 6144 + (dn ? 5120 : 2048)};
                pg8::gemm_phase<pg8::EpiResid, pg8::StaticOrder, PG8_ALIGN, PG8_SP2>(F.lds + RING_OFF, g, S, E, F.tid);
            }
            else if (s == 2) { if (ml) scan_phase(F, l); else sc_gate_phase(F, l); }
            else if (s == 3) { if (ml) ml_gate_phase(F, l); else empty = true; }
            else ffn_fixup_phase(F, l);
        }
        if (!empty && ph + 1 < hi && rep + 1 == nrep) xcd_barrier(bar);
      }
    }
}

extern "C" void kernel_launch(void* const* d_in, const int* in_sizes, int n_in, void* d_out, int out_size, void* d_ws, size_t ws_size, hipStream_t stream) {
    static int grid = 0;
    if (grid == 0) {
        if (n_in != 19 || in_sizes[0] != M * D || out_size != M * D || ws_size < WS_END) { fprintf(stderr, "kernel_launch: unexpected shapes (n_in %d, in0 %d, out %d, ws %zu < %zu); nothing launched\n", n_in, n_in > 0 ? in_sizes[0] : -1, out_size, ws_size, (size_t)WS_END); grid = -1; return; }
        int dev = 0, cus = 0, per_cu = 0;
        if (hipGetDevice(&dev) != hipSuccess || hipDeviceGetAttribute(&cus, hipDeviceAttributeMultiprocessorCount, dev) != hipSuccess) { grid = -1; return; }
        if (hipFuncSetAttribute((const void*)mk_fwd, hipFuncAttributeMaxDynamicSharedMemorySize, LDS_BYTES) != hipSuccess) { fprintf(stderr, "kernel_launch: hipFuncSetAttribute failed\n"); grid = -1; return; }
        if (hipOccupancyMaxActiveBlocksPerMultiprocessor(&per_cu, (const void*)mk_fwd, NWAVES * 64, LDS_BYTES) != hipSuccess || per_cu < 1) fprintf(stderr, "kernel_launch: occupancy query reports %d\n", per_cu);
        (void)hipGetLastError();
        grid = cus;
        if (grid != 256) { fprintf(stderr, "kernel_launch: built for 256 CUs, device has %d; nothing launched\n", grid); grid = -1; return; }
    }
    if (grid < 0) return;
    if (hipMemsetAsync((char*)d_ws + WS_CTL, 0, CTL_ZERO_BYTES, stream) != hipSuccess) return;
    Args a{};
    for (int i = 0; i < 19; ++i) a.in[i] = (const float*)d_in[i];
    a.out = (float*)d_out; a.ws = (unsigned char*)d_ws;
#if MK_SEPARATE
    for (int ph = 0; ph < NPHASES; ++ph) {
        if (ph >= 1 && ph < NPHASES - 1 && ((ph - 1) % 9) == 3 && ((((ph - 1) / 9) & 1) == 0)) continue;
        a.ph_lo = ph; a.ph_hi = ph + 1;
        hipLaunchKernelGGL(mk_fwd, dim3(grid), dim3(NWAVES * 64), LDS_BYTES, stream, a);
    }
#else
    a.ph_lo = 0; a.ph_hi = NPHASES;
    hipLaunchKernelGGL(mk_fwd, dim3(grid), dim3(NWAVES * 64), LDS_BYTES, stream, a);
#endif
}
```
